# Optimizing an MI355X kernel written in HIP

```python
import jax, jax.numpy as jnp
from jax import lax
import numpy as np

D_MODEL = 1024
BATCH = 8
SEQ = 4096
DEPTH = 1

CHUNK = 64
RWKV_HEADS = 8
RWKV_HEAD_DIM = 64
RWKV_WIDTH = RWKV_HEADS * RWKV_HEAD_DIM
DECAY_LORA = 64
ICLR_LORA = 64
GATE_LORA = 128
GDN_HEADS = 4
GDN_HEAD_DIM = 128
GDN_WIDTH = GDN_HEADS * GDN_HEAD_DIM
GDN_CONV = 4
FFN_HIDDEN = 2816
FFN_CONV = 3
NORM_EPS = 1e-6
L2_EPS = 1e-6
RWKV_GN_EPS = 64e-5

RWKV_SHIFT_WIDTH = 3 * RWKV_WIDTH + DECAY_LORA + ICLR_LORA + GATE_LORA
IN_SPLITS = (RWKV_SHIFT_WIDTH, 3 * GDN_WIDTH, GDN_WIDTH, GDN_HEADS, GDN_HEADS, D_MODEL, D_MODEL)
IN_WIDTH = RWKV_SHIFT_WIDTH + 4 * GDN_WIDTH + 2 * GDN_HEADS + 2 * D_MODEL

kernel_name = 'hybrid_rwkv7_gdn_gated_merge_block'


def _split(t, sizes):
    cuts = [int(c) for c in np.cumsum(sizes)[:-1]]
    return jnp.split(t, cuts, axis=-1)


def rms_norm(t, gain, eps=NORM_EPS):
    tf = t.astype(jnp.float32)
    y = tf * lax.rsqrt(jnp.mean(tf * tf, axis=-1, keepdims=True) + eps)
    return (y * gain.astype(jnp.float32)).astype(t.dtype)


def l2norm(t):
    tf = t.astype(jnp.float32)
    return (tf * lax.rsqrt(jnp.sum(tf * tf, axis=-1, keepdims=True) + L2_EPS)).astype(t.dtype)


def causal_depthwise_conv(t, w):
    width = w.shape[0]
    T = t.shape[1]
    tp = jnp.pad(t, ((0, 0), (width - 1, 0), (0, 0)))
    out = tp[:, 0:T] * w[0]
    for i in range(1, width):
        out = out + tp[:, i:i + T] * w[i]
    return out


def token_shift(t):
    return jnp.pad(t, ((0, 0), (1, 0), (0, 0)))[:, :-1]


def group_norm_heads(y, w, b):
    yf = y.astype(jnp.float32)
    mean = jnp.mean(yf, axis=-1, keepdims=True)
    var = jnp.mean(jnp.square(yf - mean), axis=-1, keepdims=True)
    yn = (yf - mean) * lax.rsqrt(var + RWKV_GN_EPS)
    H, D = y.shape[-2], y.shape[-1]
    return (yn * w.reshape(H, D) + b.reshape(H, D)).astype(y.dtype)


def wkv7_scan(r, w, k, v, a, b):
    dtype = r.dtype
    B, T, H, D = r.shape
    xs = tuple(jnp.moveaxis(t.astype(jnp.float32), 1, 0) for t in (r, w, k, v, a, b))

    def step(S, inp):
        r_t, w_t, k_t, v_t, a_t, b_t = inp
        sa = jnp.einsum('bhvk,bhk->bhv', S, a_t)
        S = S * w_t[:, :, None, :] + sa[..., None] * b_t[:, :, None, :] + v_t[..., None] * k_t[:, :, None, :]
        y = jnp.einsum('bhvk,bhk->bhv', S, r_t)
        return S, y

    S0 = jnp.zeros((B, H, D, D), jnp.float32)
    _, y = lax.scan(step, S0, xs)
    return jnp.moveaxis(y, 0, 1).astype(dtype)


def rwkv7_mix(p, mu, w0, w2, a0, a2, g2, k_k, k_a, r_k, ln_w, ln_b):
    B, T, _ = p.shape
    p = p + (token_shift(p) - p) * mu
    r, k, v, wl, al, gl = _split(p, (RWKV_WIDTH, RWKV_WIDTH, RWKV_WIDTH, DECAY_LORA, ICLR_LORA, GATE_LORA))
    w_log = -jax.nn.softplus(-(w0 + jnp.tanh(wl) @ w2)) - 0.5
    a = jax.nn.sigmoid(a0 + al @ a2)
    g = jax.nn.sigmoid(gl) @ g2

    def heads(t):
        return t.reshape(B, T, RWKV_HEADS, RWKV_HEAD_DIM)

    kk = l2norm(heads(k * k_k))
    k = k * (1 + (a - 1) * k_a)
    r_h, k_h, v_h, a_h = heads(r), heads(k), heads(v), heads(a)
    decay = jnp.exp(-jnp.exp(heads(w_log).astype(jnp.float32)))
    y = wkv7_scan(r_h, decay, k_h, v_h, -kk, kk * a_h)
    y = group_norm_heads(y, ln_w, ln_b)
    y = y + jnp.sum(r_h * k_h * r_k, axis=-1, keepdims=True) * v_h
    return y.reshape(B, T, RWKV_WIDTH) * g


def chunk_gated_delta_rule(q, k, v, g, beta):
    dtype = v.dtype
    B, T, H, Dk = q.shape
    Dv = v.shape[-1]
    N = T // CHUNK

    def to_chunks(t):
        t = t.astype(jnp.float32).reshape((B, N, CHUNK, H) + t.shape[3:])
        return jnp.moveaxis(t, 3, 1)

    q = to_chunks(q) * (Dk ** -0.5)
    k, v, g, beta = to_chunks(k), to_chunks(v), to_chunks(g), to_chunks(beta)
    gc = jnp.cumsum(g, axis=-1)
    causal = jnp.tril(jnp.ones((CHUNK, CHUNK), bool))
    strict = jnp.tril(jnp.ones((CHUNK, CHUNK), bool), -1)
    diff = gc[..., :, None] - gc[..., None, :]
    decay = jnp.where(causal, jnp.exp(jnp.where(causal, diff, 0.0)), 0.0)
    k_beta = k * beta[..., None]
    v_beta = v * beta[..., None]
    Lmat = jnp.where(strict, jnp.einsum('bhncd,bhnsd->bhncs', k_beta, k) * decay, 0.0)
    eye = jnp.eye(CHUNK, dtype=jnp.float32)
    Tinv = lax.linalg.triangular_solve(Lmat + eye, jnp.broadcast_to(eye, Lmat.shape),
                                       left_side=True, lower=True, unit_diagonal=True)
    u = jnp.einsum('bhncs,bhnsd->bhncd', Tinv, v_beta)
    wk = jnp.einsum('bhncs,bhnsd->bhncd', Tinv, k_beta * jnp.exp(gc)[..., None])
    attn = jnp.where(causal, jnp.einsum('bhncd,bhnsd->bhncs', q, k) * decay, 0.0)
    q_dec = q * jnp.exp(gc)[..., None]
    g_last = gc[..., -1]
    k_dec = k * jnp.exp(g_last[..., None] - gc)[..., None]
    xs = (jnp.moveaxis(q_dec, 2, 0), jnp.moveaxis(wk, 2, 0), jnp.moveaxis(u, 2, 0),
          jnp.moveaxis(attn, 2, 0), jnp.moveaxis(k_dec, 2, 0), jnp.moveaxis(g_last, 2, 0))

    def step(S, inp):
        q_n, w_n, u_n, attn_n, k_n, gl_n = inp
        v_new = u_n - jnp.einsum('bhcd,bhde->bhce', w_n, S)
        o = jnp.einsum('bhcd,bhde->bhce', q_n, S) + jnp.einsum('bhcs,bhse->bhce', attn_n, v_new)
        S = S * jnp.exp(gl_n)[..., None, None] + jnp.einsum('bhcd,bhce->bhde', k_n, v_new)
        return S, o

    S0 = jnp.zeros((B, H, Dk, Dv), jnp.float32)
    _, o = lax.scan(step, S0, xs)
    o = jnp.transpose(o, (1, 0, 3, 2, 4)).reshape(B, T, H, Dv)
    return o.astype(dtype)


def gated_deltanet_mix(qkv, z, a_raw, b_raw, conv_w, a_log, dt_bias, norm_w):
    B, T, _ = qkv.shape
    qkv = jax.nn.silu(causal_depthwise_conv(qkv, conv_w))
    q, k, v = _split(qkv, (GDN_WIDTH, GDN_WIDTH, GDN_WIDTH))
    q = l2norm(q.reshape(B, T, GDN_HEADS, GDN_HEAD_DIM))
    k = l2norm(k.reshape(B, T, GDN_HEADS, GDN_HEAD_DIM))
    v = v.reshape(B, T, GDN_HEADS, GDN_HEAD_DIM)
    beta = jax.nn.sigmoid(b_raw)
    g = -jnp.exp(a_log.astype(jnp.float32)) * jax.nn.softplus(a_raw.astype(jnp.float32) + dt_bias.astype(jnp.float32))
    o = chunk_gated_delta_rule(q, k, v, g, beta)
    o = rms_norm(o, norm_w) * jax.nn.silu(z.reshape(B, T, GDN_HEADS, GDN_HEAD_DIM))
    return o.reshape(B, T, GDN_WIDTH)


def setup_inputs(seed: int = 0) -> dict:
    key = jax.random.key(seed)
    ks = jax.random.split(key, 32)
    L = DEPTH

    def nrm(k, shape, scale):
        return jax.random.normal(k, shape, jnp.float32) * scale

    dt = jnp.exp(jax.random.uniform(ks[17], (L, GDN_HEADS), minval=float(np.log(1e-3)), maxval=float(np.log(1e-1))))
    return {
        'x': nrm(ks[0], (BATCH, SEQ, D_MODEL), 1.0),
        'norm1_g': 1.0 + nrm(ks[1], (L, D_MODEL), 0.02),
        'w_in': nrm(ks[2], (L, D_MODEL, IN_WIDTH), D_MODEL ** -0.5),
        'rwkv_mu': jax.random.uniform(ks[3], (L, RWKV_SHIFT_WIDTH)),
        'rwkv_w0': jax.random.uniform(ks[4], (L, RWKV_WIDTH), minval=-6.5, maxval=-1.0),
        'rwkv_w2': nrm(ks[5], (L, DECAY_LORA, RWKV_WIDTH), 0.5 * DECAY_LORA ** -0.5),
        'rwkv_a0': nrm(ks[6], (L, RWKV_WIDTH), 0.1),
        'rwkv_a2': nrm(ks[7], (L, ICLR_LORA, RWKV_WIDTH), 0.5 * ICLR_LORA ** -0.5),
        'rwkv_g2': nrm(ks[8], (L, GATE_LORA, RWKV_WIDTH), GATE_LORA ** -0.5),
        'rwkv_k_k': 0.85 + nrm(ks[9], (L, RWKV_WIDTH), 0.05),
        'rwkv_k_a': 1.0 + nrm(ks[10], (L, RWKV_WIDTH), 0.05),
        'rwkv_r_k': nrm(ks[11], (L, RWKV_HEADS, RWKV_HEAD_DIM), 0.1),
        'rwkv_ln_w': 1.0 + nrm(ks[12], (L, RWKV_WIDTH), 0.02),
        'rwkv_ln_b': nrm(ks[13], (L, RWKV_WIDTH), 0.02),
        'rwkv_proj': nrm(ks[14], (L, RWKV_WIDTH, D_MODEL), RWKV_WIDTH ** -0.5),
        'gdn_conv_w': nrm(ks[15], (L, GDN_CONV, 3 * GDN_WIDTH), GDN_CONV ** -0.5),
        'gdn_a_log': jnp.log(jax.random.uniform(ks[16], (L, GDN_HEADS), minval=1.0, maxval=16.0)),
        'gdn_dt_bias': dt + jnp.log(-jnp.expm1(-dt)),
        'gdn_norm_w': 1.0 + nrm(ks[18], (L, GDN_HEAD_DIM), 0.02),
        'gdn_proj': nrm(ks[19], (L, GDN_WIDTH, D_MODEL), GDN_WIDTH ** -0.5),
        'w_out': nrm(ks[20], (L, D_MODEL, D_MODEL), D_MODEL ** -0.5),
        'norm2_g': 1.0 + nrm(ks[21], (L, D_MODEL), 0.02),
        'ffn_up': nrm(ks[22], (L, D_MODEL, 2 * FFN_HIDDEN), D_MODEL ** -0.5),
        'ffn_conv_w': nrm(ks[23], (L, FFN_CONV, 2 * FFN_HIDDEN), FFN_CONV ** -0.5),
        'ffn_down': nrm(ks[24], (L, FFN_HIDDEN, D_MODEL), FFN_HIDDEN ** -0.5),
        'final_g': 1.0 + nrm(ks[25], (D_MODEL,), 0.02),
    }


def reference(x, norm1_g, w_in, rwkv_mu, rwkv_w0, rwkv_w2, rwkv_a0, rwkv_a2, rwkv_g2, rwkv_k_k,
              rwkv_k_a, rwkv_r_k, rwkv_ln_w, rwkv_ln_b, rwkv_proj, gdn_conv_w, gdn_a_log, gdn_dt_bias,
              gdn_norm_w, gdn_proj, w_out, norm2_g, ffn_up, ffn_conv_w, ffn_down, final_g):
    for l in range(DEPTH):
        u = rms_norm(x, norm1_g[l])
        p = u @ w_in[l]
        p_rwkv, qkv, z, a_raw, b_raw, gate_a, gate_b = _split(p, IN_SPLITS)
        y_a = rwkv7_mix(p_rwkv, rwkv_mu[l], rwkv_w0[l], rwkv_w2[l], rwkv_a0[l], rwkv_a2[l], rwkv_g2[l],
                        rwkv_k_k[l], rwkv_k_a[l], rwkv_r_k[l], rwkv_ln_w[l], rwkv_ln_b[l]) @ rwkv_proj[l]
        y_b = gated_deltanet_mix(qkv, z, a_raw, b_raw, gdn_conv_w[l], gdn_a_log[l], gdn_dt_bias[l],
                                 gdn_norm_w[l]) @ gdn_proj[l]
        mixed = jax.nn.sigmoid(gate_a) * y_a + jax.nn.sigmoid(gate_b) * y_b
        x = x + mixed @ w_out[l]
        h = rms_norm(x, norm2_g[l]) @ ffn_up[l]
        h = causal_depthwise_conv(h, ffn_conv_w[l])
        h_gate, h_up = _split(h, (FFN_HIDDEN, FFN_HIDDEN))
        x = x + (jax.nn.silu(h_gate) * h_up) @ ffn_down[l]
    return rms_norm(x, final_g)
```

```cpp
#include <hip/hip_runtime.h>
#include <hip/hip_cooperative_groups.h>
#include <cstdio>
#include <cstdint>
namespace cg = cooperative_groups;
namespace pg8 {
#define PG8_LAS __attribute__((address_space(3)))
typedef unsigned short bf16_t;
typedef short bf16x8 __attribute__((ext_vector_type(8)));
typedef float f32x4 __attribute__((ext_vector_type(4)));
typedef unsigned u32x4 __attribute__((ext_vector_type(4)));
constexpr int BM = 256, BK = 64, HALF = 128, HTB = HALF * BK * 2  , STAGE_BYTES = 8 * HTB, NXCD = 8, WGM = 8;

__host__ __device__ __forceinline__ int lds_byte(int r, int c) { const int st = (r >> 4) * 2 + (c >> 5), rr = r & 15, cc = c & 31, ob = rr * 64 + cc * 2; return st * 1024 + (ob ^ (((ob >> 9) & 1) << 5)); }
__host__ __device__ __forceinline__ void stage_rc(int b, int& R, int& C) { const int st = b / 1024, sb = b % 1024, swz = sb ^ (((sb >> 9) & 1) << 5); R = (st >> 1) * 16 + swz / 64; C = (st & 1) * 32 + (swz % 64) / 2; }
__host__ __device__ __forceinline__ int perm32(int rho) { const int n = rho >> 4, i = rho & 15; return 8 * (i >> 2) + 4 * n + (i & 3); }

struct Unit { int pm, pn; };
struct Gemm { const bf16_t* A; const bf16_t* Bt; int M, N, K; };

struct StaticOrder {
    int nM, nN, nwg, G, c;
    __host__ __device__ void init(int M, int N, int G_, int c_) { nM = M / BM; nN = N / BM; nwg = nM * nN; G = G_; c = c_; }
    __host__ __device__ bool next(int i, Unit& u) const {
        const long L = (long)i * G + c; if (L >= nwg) return false;
        int wgid = (int)L; { const int q = nwg / NXCD, r = nwg % NXCD, xcd = wgid % NXCD, off = wgid / NXCD; wgid = (xcd < r ? xcd * (q + 1) : r * (q + 1) + (xcd - r) * q) + off; }
        const int nig = WGM * nN, gid = wgid / nig, fm = gid * WGM, gsz = (nM - fm) < WGM ? (nM - fm) : WGM;
        u.pm = fm + ((wgid % nig) % gsz); u.pn = (wgid % nig) / gsz; return true;
    }
    __device__ __forceinline__ void a_ready(const Unit&) const {}
    __device__ __forceinline__ void done(const Unit&) const {}
};

__device__ __forceinline__ unsigned cvt_pk_bf16(float lo, float hi) { unsigned r; asm volatile("v_cvt_pk_bf16_f32 %0, %1, %2" : "=v"(r) : "v"(lo), "v"(hi)); return r; }
typedef float f32x2 __attribute__((ext_vector_type(2)));
template <class Epi, class Sched, bool ALIGN_EPI = false, bool SP2 = false>
__device__ __forceinline__ void gemm_phase(PG8_LAS unsigned char* lds, const Gemm g, const Sched& S, const Epi& E) {
    const int tid = threadIdx.x, wid = __builtin_amdgcn_readfirstlane(tid >> 6), lane = tid & 63, wr = wid >> 2, wc = wid & 3, fr = lane & 15, fq = lane >> 4;
    const int K = g.K, nt = K / BK;
    unsigned voffA[2], voffB[2];
#pragma unroll
    for (int i = 0; i < 2; ++i) { int R, C; stage_rc(tid * 16 + i * 8192, R, C); const int Rb = Epi::PERM ? ((R & ~31) + perm32(R & 31)) : R;
        voffA[i] = (unsigned)(R * K + C) * 2u; voffB[i] = (unsigned)(Rb * K + C) * 2u; }
    const size_t kstep = (size_t)(BK * 2);
    const size_t hstep = (size_t)HALF * K * 2;
    const size_t tstep = 2 * hstep;
    const unsigned ldsw = (unsigned)wid * 1024u;
    const int aoff = lds_byte(wr * 64 + fr, fq * 8), boff = lds_byte(wc * 32 + fr, fq * 8);
#define PG8_SA(b, h) (((b) * 2 + (h)) * HTB)
#define PG8_SB(b, h) ((4 + (b) * 2 + (h)) * HTB)
#define PG8_STAGE(bufoff, gbase, voff) do { _Pragma("unroll") for (int _i = 0; _i < 2; ++_i) \
        __builtin_amdgcn_global_load_lds((const unsigned*)((const char*)(gbase) + (voff)[_i]), (PG8_LAS unsigned*)(lds + (bufoff) + ldsw + _i * 8192), 16, 0, 0); } while (0)
#define PG8_LDA(dst, b, h) do { _Pragma("unroll") for (int m = 0; m < 4; ++m) _Pragma("unroll") for (int k = 0; k < 2; ++k) dst[m][k] = *(const PG8_LAS bf16x8*)(lds + PG8_SA(b, h) + aoff + m * 2048 + k * 1024); } while (0)
#define PG8_LDB(dst, b, h) do { _Pragma("unroll") for (int n = 0; n < 2; ++n) _Pragma("unroll") for (int k = 0; k < 2; ++k) dst[n][k] = *(const PG8_LAS bf16x8*)(lds + PG8_SB(b, h) + boff + n * 2048 + k * 1024); } while (0)
#define PG8_MMA(ai, bj, At, Bt) do { __builtin_amdgcn_s_setprio(1); _Pragma("unroll") for (int m = 0; m < 4; ++m) _Pragma("unroll") for (int n = 0; n < 2; ++n) _Pragma("unroll") for (int k = 0; k < 2; ++k) \
        acc[ai][bj][m][n] = __builtin_amdgcn_mfma_f32_16x16x32_bf16(Bt[n][k], At[m][k], acc[ai][bj][m][n], 0, 0, 0); __builtin_amdgcn_s_setprio(0); } while (0)
#define PG8_WAIT_V(n) asm volatile("s_waitcnt vmcnt(" #n ")" ::: "memory")
#define PG8_WAIT_L(n) asm volatile("s_waitcnt lgkmcnt(" #n ")" ::: "memory")
#define PG8_BAR __builtin_amdgcn_s_barrier()
#define PG8_SCHED __builtin_amdgcn_sched_barrier(0)
    Unit cur, nxt; int ui = 0;
    if (!S.next(0, cur)) return;
    f32x4 acc[2][2][4][2];
#pragma unroll
    for (int a = 0; a < 2; ++a)
#pragma unroll
        for (int b = 0; b < 2; ++b)
#pragma unroll
            for (int m = 0; m < 4; ++m)
#pragma unroll
                for (int n = 0; n < 2; ++n) acc[a][b][m][n] = (f32x4){0.f, 0.f, 0.f, 0.f};
    bf16x8 At[4][2], B0[2][2], B1[2][2];
    const char* cA = (const char*)g.A + (size_t)cur.pm * tstep; const char* cB = (const char*)g.Bt + (size_t)cur.pn * tstep;
    S.a_ready(cur);
    if constexpr (SP2) {
        PG8_STAGE(PG8_SB(0, 0), cB, voffB); PG8_STAGE(PG8_SB(0, 1), cB + hstep, voffB); PG8_STAGE(PG8_SA(0, 0), cA, voffA); PG8_STAGE(PG8_SA(0, 1), cA + hstep, voffA);
        if (wr == 1) PG8_BAR;
        PG8_WAIT_V(2); PG8_BAR;
        PG8_STAGE(PG8_SB(1, 0), cB + kstep, voffB); PG8_STAGE(PG8_SA(1, 0), cA + kstep, voffA); PG8_STAGE(PG8_SB(1, 1), cB + hstep + kstep, voffB);
        PG8_WAIT_V(6); PG8_BAR;
    } else {
        PG8_STAGE(PG8_SB(0, 0), cB, voffB); PG8_STAGE(PG8_SA(0, 0), cA, voffA); PG8_STAGE(PG8_SB(0, 1), cB + hstep, voffB); PG8_STAGE(PG8_SA(0, 1), cA + hstep, voffA);
        if (wr == 1) PG8_BAR;
        PG8_WAIT_V(4); PG8_BAR;
        PG8_STAGE(PG8_SB(1, 0), cB + kstep, voffB); PG8_STAGE(PG8_SA(1, 0), cA + kstep, voffA); PG8_STAGE(PG8_SB(1, 1), cB + hstep + kstep, voffB);
        PG8_WAIT_V(6); PG8_BAR;
    }
    for (;;) {
        const bool has_next = S.next(ui + 1, nxt);
        const char* nA = has_next ? (const char*)g.A + (size_t)nxt.pm * tstep : cA; const char* nB = has_next ? (const char*)g.Bt + (size_t)nxt.pn * tstep : cB;
        for (int t = 0; t < nt; t += 2) {
            const bool last = (t == nt - 2);
            const char* a1 = cA + (size_t)(t + 1) * kstep;
            const char* a2 = last ? nA : cA + (size_t)(t + 2) * kstep; const char* b2 = last ? nB : cB + (size_t)(t + 2) * kstep;
            const char* a3 = a2 + kstep; const char* b3 = b2 + kstep;
            if (last && has_next) S.a_ready(nxt);
            if constexpr (SP2) {
            PG8_LDB(B0, 0, 0); PG8_LDB(B1, 0, 1); PG8_SCHED; PG8_LDA(At, 0, 0); PG8_STAGE(PG8_SA(1, 1), a1 + hstep, voffA);
            PG8_WAIT_V(8); PG8_WAIT_L(0); PG8_BAR; PG8_MMA(0, 0, At, B0); PG8_MMA(0, 1, At, B1); PG8_BAR; PG8_SCHED;
            PG8_LDA(At, 0, 1); PG8_STAGE(PG8_SB(0, 0), b2, voffB); PG8_STAGE(PG8_SB(0, 1), b2 + hstep, voffB); PG8_STAGE(PG8_SA(0, 0), a2, voffA);
            PG8_WAIT_V(8); PG8_WAIT_L(0); PG8_BAR; PG8_MMA(1, 0, At, B0); PG8_MMA(1, 1, At, B1); PG8_BAR; PG8_SCHED;
            PG8_LDB(B0, 1, 0); PG8_LDB(B1, 1, 1); PG8_SCHED; PG8_LDA(At, 1, 0); PG8_STAGE(PG8_SA(0, 1), a2 + hstep, voffA);
            PG8_WAIT_V(8); PG8_WAIT_L(0); PG8_BAR; PG8_MMA(0, 0, At, B0); PG8_MMA(0, 1, At, B1); PG8_BAR; PG8_SCHED;
            PG8_LDA(At, 1, 1); PG8_STAGE(PG8_SB(1, 0), b3, voffB); PG8_STAGE(PG8_SB(1, 1), b3 + hstep, voffB); PG8_STAGE(PG8_SA(1, 0), a3, voffA);
            PG8_WAIT_V(8); PG8_WAIT_L(0); PG8_BAR; PG8_MMA(1, 0, At, B0); PG8_MMA(1, 1, At, B1); PG8_BAR; PG8_SCHED;
            } else {
            PG8_LDB(B0, 0, 0); PG8_SCHED; PG8_LDA(At, 0, 0); PG8_STAGE(PG8_SA(1, 1), a1 + hstep, voffA);
            PG8_WAIT_L(8); PG8_BAR; PG8_WAIT_L(0); PG8_MMA(0, 0, At, B0); PG8_BAR; PG8_SCHED;
            PG8_LDB(B1, 0, 1); PG8_STAGE(PG8_SB(0, 0), b2, voffB);
            PG8_BAR; PG8_WAIT_L(0); PG8_MMA(0, 1, At, B1); PG8_BAR;
            PG8_LDA(At, 0, 1); PG8_STAGE(PG8_SA(0, 0), a2, voffA);
            PG8_BAR; PG8_WAIT_L(0); PG8_MMA(1, 0, At, B0); PG8_BAR; PG8_SCHED;
            PG8_STAGE(PG8_SB(0, 1), b2 + hstep, voffB);
            PG8_WAIT_V(6); PG8_BAR; PG8_MMA(1, 1, At, B1); PG8_BAR;
            PG8_LDB(B0, 1, 0); PG8_SCHED; PG8_LDA(At, 1, 0); PG8_STAGE(PG8_SA(0, 1), a2 + hstep, voffA);
            PG8_WAIT_L(8); PG8_BAR; PG8_WAIT_L(0); PG8_MMA(0, 0, At, B0); PG8_BAR; PG8_SCHED;
            PG8_LDB(B1, 1, 1); PG8_STAGE(PG8_SB(1, 0), b3, voffB);
            PG8_BAR; PG8_WAIT_L(0); PG8_MMA(0, 1, At, B1); PG8_BAR;
            PG8_LDA(At, 1, 1); PG8_STAGE(PG8_SA(1, 0), a3, voffA);
            PG8_BAR; PG8_WAIT_L(0); PG8_MMA(1, 0, At, B0); PG8_BAR; PG8_SCHED;
            PG8_STAGE(PG8_SB(1, 1), b3 + hstep, voffB);
            PG8_WAIT_V(6); PG8_BAR; PG8_MMA(1, 1, At, B1); PG8_BAR;
            }
        }
        if constexpr (ALIGN_EPI) { if (wr == 0) PG8_BAR; }
        if constexpr (!Epi::AFTER_DRAIN) { E(acc, cur, wr, wc, fr, fq); S.done(cur); }
        if (!has_next) break;
#pragma unroll
        for (int a = 0; a < 2; ++a)
#pragma unroll
            for (int b = 0; b < 2; ++b)
#pragma unroll
                for (int m = 0; m < 4; ++m)
#pragma unroll
                    for (int n = 0; n < 2; ++n) acc[a][b][m][n] = (f32x4){0.f, 0.f, 0.f, 0.f};
        cur = nxt; cA = nA; cB = nB; ++ui;
        if constexpr (ALIGN_EPI) { if (wr == 1) PG8_BAR; }
    }
    PG8_WAIT_V(0);
    if constexpr (!ALIGN_EPI) { if (wr == 0) PG8_BAR; }
    PG8_BAR;
    if constexpr (Epi::AFTER_DRAIN) { E.fused(acc, cur, wr, wc, fr, fq, lds, wid, lane); S.done(cur); }
#undef PG8_SA
#undef PG8_SB
#undef PG8_STAGE
#undef PG8_LDA
#undef PG8_LDB
#undef PG8_MMA
#undef PG8_WAIT_V
#undef PG8_WAIT_L
#undef PG8_BAR
#undef PG8_SCHED
}
}

#define LAS __attribute__((address_space(3)))
typedef unsigned short bf16;
typedef unsigned u32x4 __attribute__((ext_vector_type(4)));
typedef unsigned u32x2 __attribute__((ext_vector_type(2)));
typedef float f32x4 __attribute__((ext_vector_type(4)));
typedef float f32x2 __attribute__((ext_vector_type(2)));

constexpr int NWAVES = 8;
constexpr int M_TOK = 32768, TSEQ = 4096, DM = 1024;
constexpr int NP1 = 5888;
constexpr int FFH = 2816, FF2 = 5632;
constexpr size_t MiB = 1u << 20;
constexpr size_t WS_CTL = 0, CTL_ZERO_BYTES = 1 * MiB;
constexpr size_t CTL_RS2 = 256 * 1024, CTL_RS3 = 384 * 1024;
constexpr size_t WS_WIN = 1 * MiB, WS_WPROJ = 13 * MiB, WS_WOUT = 15 * MiB, WS_WLORA = 17 * MiB;
constexpr size_t WS_PG = 18 * MiB, WS_PZ = 146 * MiB, WS_PQ = 178 * MiB, WS_XN = 274 * MiB;
constexpr size_t WS_GV = 338 * MiB, WS_R = 370 * MiB, WS_K = 402 * MiB, WS_V = 434 * MiB, WS_KK = 466 * MiB;
constexpr size_t WS_ALPHA = 498 * MiB, WS_BETA = 499 * MiB;
constexpr size_t WS_BP = 178 * MiB, WS_G = 210 * MiB, WS_WUP = 242 * MiB, WS_WDN = 253 * MiB;
constexpr size_t WS_GQ = 274 * MiB, WS_GK = 306 * MiB;
constexpr size_t WS_YAB = 274 * MiB, WS_MIX = 370 * MiB, WS_X2B = 434 * MiB;
constexpr size_t WS_H = 18 * MiB, WS_ACT = 274 * MiB;
constexpr size_t WS_NEED = 512 * MiB;
constexpr size_t DO_PR = 0, DO_ALORA = 112 * MiB, DO_DEC = 0, DO_Y = 64 * MiB, DO_O = 96 * MiB;

constexpr int LDS_BYTES = 147456;
#ifndef PHMASK
#define PHMASK 0xFFFFu
#endif

__device__ __forceinline__ float bf_lo(unsigned u) { return __uint_as_float(u << 16); }
__device__ __forceinline__ float bf_hi(unsigned u) { return __uint_as_float(u & 0xffff0000u); }
__device__ __forceinline__ unsigned pk2(float lo, float hi) { return pg8::cvt_pk_bf16(lo, hi); }
__device__ __forceinline__ void unpack8(const u32x4 u, float (&f)[8]) {
    f[0] = bf_lo(u.x); f[1] = bf_hi(u.x); f[2] = bf_lo(u.y); f[3] = bf_hi(u.y); f[4] = bf_lo(u.z); f[5] = bf_hi(u.z); f[6] = bf_lo(u.w); f[7] = bf_hi(u.w);
}
__device__ __forceinline__ u32x4 pack8(const float (&f)[8]) { u32x4 o; o.x = pk2(f[0], f[1]); o.y = pk2(f[2], f[3]); o.z = pk2(f[4], f[5]); o.w = pk2(f[6], f[7]); return o; }
__device__ __forceinline__ float sigmoidf_(float x) { return 1.0f / (1.0f + __expf(-x)); }
__device__ __forceinline__ float siluf_(float x) { return x * sigmoidf_(x); }
#define LDS_WAIT() asm volatile("s_waitcnt lgkmcnt(0)" ::: "memory")
#define WG_BAR() do { asm volatile("s_waitcnt lgkmcnt(0)" ::: "memory"); __builtin_amdgcn_s_barrier(); asm volatile("" ::: "memory"); } while (0)

template <int CTRL> __device__ __forceinline__ float dppf(float x) {
    return __int_as_float(__builtin_amdgcn_update_dpp(0, __float_as_int(x), CTRL, 0xF, 0xF, true));
}
__device__ __forceinline__ float red16(float x) { x += dppf<0xB1>(x); x += dppf<0x4E>(x); x += dppf<0x141>(x); x += dppf<0x140>(x); return x; }
__device__ __forceinline__ float red8(float x) { x += dppf<0xB1>(x); x += dppf<0x4E>(x); x += dppf<0x141>(x); return x; }
__device__ __forceinline__ float wave_sum(float v) {
#pragma unroll
    for (int o = 1; o < 64; o <<= 1) v += __shfl_xor(v, o);
    return v;
}

__device__ __forceinline__ void tr_item(const float* __restrict__ W, int ldw, int src_col, int k0, bf16* __restrict__ WT, int ldk, int dst_row,
                                        const float* __restrict__ gain, LAS float* scr, int lane) {
#pragma unroll 8
    for (int i = 0; i < 32; ++i) { const int kk = 2 * i + (lane >> 5); float g = gain ? gain[k0 + kk] : 1.0f;
        scr[kk * 33 + (lane & 31)] = W[(size_t)(k0 + kk) * ldw + src_col + (lane & 31)] * g; }
    LDS_WAIT(); asm volatile("" ::: "memory");
    const int c = lane & 7;
#pragma unroll
    for (int j = 0; j < 4; ++j) { const int n = (lane >> 3) + 8 * j; const LAS float* s = scr + (8 * c) * 33 + n;
        u32x4 o; o.x = pk2(s[0 * 33], s[1 * 33]); o.y = pk2(s[2 * 33], s[3 * 33]); o.z = pk2(s[4 * 33], s[5 * 33]); o.w = pk2(s[6 * 33], s[7 * 33]);
        *(u32x4*)(WT + (size_t)(dst_row + n) * ldk + k0 + 8 * c) = o; }
    LDS_WAIT(); asm volatile("" ::: "memory");
}

struct EpiP1 {
    static constexpr bool PERM = true, AFTER_DRAIN = false;
    bf16 *PR, *PQ, *PZ, *PG;
    __device__ __forceinline__ void operator()(const pg8::f32x4 (&acc)[2][2][4][2], const pg8::Unit& u, int wr, int wc, int fr, int fq) const {
        bf16* base; int ld, ct; const int pn = u.pn;
        if (pn < 7) { base = PR; ld = 1792; ct = pn; } else if (pn < 13) { base = PQ; ld = 1536; ct = pn - 7; } else if (pn < 15) { base = PZ; ld = 512; ct = pn - 13; } else { base = PG; ld = 2048; ct = pn - 15; }
        const int row0 = u.pm * 256 + wr * 64 + fr, col0 = ct * 256 + wc * 32 + 8 * fq;
#pragma unroll
        for (int ai = 0; ai < 2; ++ai)
#pragma unroll
            for (int m = 0; m < 4; ++m) { bf16* rowp = base + (size_t)(row0 + ai * 128 + m * 16) * ld + col0;
#pragma unroll
                for (int bj = 0; bj < 2; ++bj) { const pg8::f32x4 v0 = acc[ai][bj][m][0], v1 = acc[ai][bj][m][1];
                    u32x4 w; w.x = pk2(v0[0], v0[1]); w.y = pk2(v0[2], v0[3]); w.z = pk2(v1[0], v1[1]); w.w = pk2(v1[2], v1[3]);
                    *(u32x4*)(rowp + bj * 128) = w; } }
    }
};
struct EpiP3 {
    static constexpr bool PERM = true, AFTER_DRAIN = false;
    float* DEC; bf16* K; const bf16* KK; bf16* BP; bf16* G; const float *w0, *a0, *k_a;
    __device__ __forceinline__ void operator()(const pg8::f32x4 (&acc)[2][2][4][2], const pg8::Unit& u, int wr, int wc, int fr, int fq) const {
        const int grp = u.pn >> 1;
        const int row0 = u.pm * 256 + wr * 64 + fr, col0 = (u.pn & 1) * 256 + wc * 32 + 8 * fq;
#pragma unroll
        for (int ai = 0; ai < 2; ++ai)
#pragma unroll
            for (int m = 0; m < 4; ++m) {
#pragma unroll
                for (int bj = 0; bj < 2; ++bj) {
                    const int col = col0 + bj * 128;
                    const size_t off = (size_t)(row0 + ai * 128 + m * 16) * 512 + col;
                    const pg8::f32x4 v0 = acc[ai][bj][m][0], v1 = acc[ai][bj][m][1];
                    float v[8] = {v0[0], v0[1], v0[2], v0[3], v1[0], v1[1], v1[2], v1[3]};
                    if (grp == 0) {
                        const f32x4 pa = *(const f32x4*)(w0 + col), pb = *(const f32x4*)(w0 + col + 4);
                        const float p0[8] = {pa[0], pa[1], pa[2], pa[3], pb[0], pb[1], pb[2], pb[3]};
                        float d[8];
#pragma unroll
                        for (int e = 0; e < 8; ++e) d[e] = __expf(-0.60653065971f * sigmoidf_(p0[e] + v[e]));
                        *(f32x4*)(DEC + off) = (f32x4){d[0], d[1], d[2], d[3]}; *(f32x4*)(DEC + off + 4) = (f32x4){d[4], d[5], d[6], d[7]};
                    } else if (grp == 1) {
                        const f32x4 pa = *(const f32x4*)(a0 + col), pb = *(const f32x4*)(a0 + col + 4), pc = *(const f32x4*)(k_a + col), pd = *(const f32x4*)(k_a + col + 4);
                        const float p0[8] = {pa[0], pa[1], pa[2], pa[3], pb[0], pb[1], pb[2], pb[3]}, p1[8] = {pc[0], pc[1], pc[2], pc[3], pd[0], pd[1], pd[2], pd[3]};
                        float kr[8], kkv[8], kp[8], bp[8];
                        unpack8(*(const u32x4*)(K + off), kr); unpack8(*(const u32x4*)(KK + off), kkv);
#pragma unroll
                        for (int e = 0; e < 8; ++e) { const float a = sigmoidf_(p0[e] + v[e]); kp[e] = kr[e] * (1.0f + (a - 1.0f) * p1[e]); bp[e] = kkv[e] * a; }
                        *(u32x4*)(K + off) = pack8(kp); *(u32x4*)(BP + off) = pack8(bp);
                    } else {
                        *(u32x4*)(G + off) = pack8(v);
                    }
                    asm volatile("" ::: "memory");
                }
            }
    }
};
struct EpiP6 {
    static constexpr bool PERM = true, AFTER_DRAIN = false;
    const bf16* PG; bf16* MIX;
    __device__ __forceinline__ void operator()(const pg8::f32x4 (&acc)[2][2][4][2], const pg8::Unit& u, int wr, int wc, int fr, int fq) const {
        const int which = u.pm >= 128 ? 1 : 0, pm = u.pm - 128 * which, pn = u.pn - 4 * which;
        const int row0 = pm * 256 + wr * 64 + fr, col0 = pn * 256 + wc * 32 + 8 * fq;
#pragma unroll
        for (int ai = 0; ai < 2; ++ai)
#pragma unroll
            for (int m = 0; m < 4; ++m) { const size_t r = (size_t)(row0 + ai * 128 + m * 16);
#pragma unroll
                for (int bj = 0; bj < 2; ++bj) { const int col = col0 + bj * 128;
                    const pg8::f32x4 v0 = acc[ai][bj][m][0], v1 = acc[ai][bj][m][1];
                    float v[8] = {v0[0], v0[1], v0[2], v0[3], v1[0], v1[1], v1[2], v1[3]}, g[8];
                    unpack8(*(const u32x4*)(PG + r * 2048 + which * 1024 + col), g);
#pragma unroll
                    for (int e = 0; e < 8; ++e) v[e] *= sigmoidf_(g[e]);
                    if (which) { float pv[8]; unpack8(*(const u32x4*)(MIX + r * 1024 + col), pv);
#pragma unroll
                        for (int e = 0; e < 8; ++e) v[e] += pv[e]; }
                    *(u32x4*)(MIX + r * 1024 + col) = pack8(v); } asm volatile("" ::: "memory"); }
    }
};
struct EpiRes {
    static constexpr bool PERM = true, AFTER_DRAIN = false;
    const float* BASE; float* OUT; bf16* OUTB; float* RSACC; int row_off;
    __device__ __forceinline__ void operator()(const pg8::f32x4 (&acc)[2][2][4][2], const pg8::Unit& u, int wr, int wc, int fr, int fq) const {
        const int row0 = row_off + u.pm * 256 + wr * 64 + fr, col0 = u.pn * 256 + wc * 32 + 8 * fq;
#pragma unroll
        for (int ai = 0; ai < 2; ++ai)
#pragma unroll
            for (int m = 0; m < 4; ++m) { const size_t r = (size_t)(row0 + ai * 128 + m * 16); float ss = 0.f;
#pragma unroll
                for (int bj = 0; bj < 2; ++bj) { const size_t off = r * 1024 + col0 + bj * 128;
                    const f32x4 b0 = *(const f32x4*)(BASE + off), b1 = *(const f32x4*)(BASE + off + 4);
                    const pg8::f32x4 v0 = acc[ai][bj][m][0], v1 = acc[ai][bj][m][1];
                    float v[8] = {v0[0] + b0[0], v0[1] + b0[1], v0[2] + b0[2], v0[3] + b0[3], v1[0] + b1[0], v1[1] + b1[1], v1[2] + b1[2], v1[3] + b1[3]};
#pragma unroll
                    for (int e = 0; e < 8; ++e) ss += v[e] * v[e];
                    *(f32x4*)(OUT + off) = (f32x4){v[0], v[1], v[2], v[3]}; *(f32x4*)(OUT + off + 4) = (f32x4){v[4], v[5], v[6], v[7]};
                    if (OUTB) *(u32x4*)(OUTB + off) = pack8(v); }
                ss += __shfl_xor(ss, 16); ss += __shfl_xor(ss, 32);
                if (fq == 0) atomicAdd(RSACC + r, ss); asm volatile("" ::: "memory"); }
    }
};
struct EpiP8 {
    static constexpr bool PERM = true, AFTER_DRAIN = false;
    bf16* H; const float* RSACC; int row_off;
    __device__ __forceinline__ void operator()(const pg8::f32x4 (&acc)[2][2][4][2], const pg8::Unit& u, int wr, int wc, int fr, int fq) const {
        const int row0 = u.pm * 256 + wr * 64 + fr, col0 = u.pn * 256 + wc * 32 + 8 * fq;
#pragma unroll
        for (int ai = 0; ai < 2; ++ai)
#pragma unroll
            for (int m = 0; m < 4; ++m) { const int r = row0 + ai * 128 + m * 16; const float rs = __frsqrt_rn(RSACC[row_off + r] * (1.0f / 1024.0f) + 1e-6f);
#pragma unroll
                for (int bj = 0; bj < 2; ++bj) { const pg8::f32x4 v0 = acc[ai][bj][m][0] * rs, v1 = acc[ai][bj][m][1] * rs;
                    u32x4 w; w.x = pk2(v0[0], v0[1]); w.y = pk2(v0[2], v0[3]); w.z = pk2(v1[0], v1[1]); w.w = pk2(v1[2], v1[3]);
                    *(u32x4*)(H + (size_t)r * FF2 + col0 + bj * 128) = w; } asm volatile("" ::: "memory"); }
    }
};
struct PairOrder {
    pg8::StaticOrder base;
    __device__ void init(int G, int c) { base.init(M_TOK, 1024, G, c); }
    __device__ bool next(int i, pg8::Unit& u) const { pg8::Unit b; if (!base.next(i >> 1, b)) return false; const int w = i & 1; u.pm = b.pm + 128 * w; u.pn = b.pn + 4 * w; return true; }
    __device__ __forceinline__ void a_ready(const pg8::Unit&) const {}
    __device__ __forceinline__ void done(const pg8::Unit&) const {}
};

constexpr int TS = 16;
constexpr int RW_STEP = 336, RW_BUF = TS * RW_STEP;
constexpr int GD_STEP = 276, GD_BUF = TS * GD_STEP;
constexpr int GD_LDS_OFF = 2 * RW_BUF;

__device__ __forceinline__ void rwkv_scan(LAS float* lds, const bf16* __restrict__ R, const bf16* __restrict__ Kp, const bf16* __restrict__ KK, const bf16* __restrict__ BP,
                                          const float* __restrict__ DEC, const bf16* __restrict__ V, bf16* __restrict__ Y, int tid, int lane, int wave) {
    const int pair = blockIdx.x >> 2, s = blockIdx.x & 3, b = pair >> 3, h = pair & 7;
    const size_t mrow0 = (size_t)b * TSEQ; const int colh = h * 64; const int i = tid;
    const int a_arr = i >> 7, a_step = (i & 127) >> 3, a_seg = i & 7;
    const bf16* srcA0 = (a_arr == 0 ? R : Kp) + (mrow0 + a_step) * 512 + colh + a_seg * 8;
    const bf16* srcA1 = (a_arr == 0 ? KK : BP) + (mrow0 + a_step) * 512 + colh + a_seg * 8;
    const int d_step = i >> 4, d_seg = i & 15;
    const float* srcD = DEC + (mrow0 + d_step) * 512 + colh + d_seg * 4;
    const int v_step = (i >> 1) & 15, v_seg = i & 1;
    const bf16* srcV = V + (mrow0 + v_step) * 512 + colh + 16 * s + v_seg * 8;
    const int dA0 = a_step * RW_STEP + (a_arr == 0 ? 0 : 128) + a_seg * 8;
    const int dA1 = a_step * RW_STEP + (a_arr == 0 ? 192 : 256) + a_seg * 8;
    const float sg1 = a_arr == 0 ? -1.0f : 1.0f;
    const int dD = d_step * RW_STEP + 64 + d_seg * 4, dV = v_step * RW_STEP + 320 + v_seg * 8;
    const int kq = lane & 15, rl = wave * 4 + (lane >> 4);
    float S0 = 0.f, S1 = 0.f, S2 = 0.f, S3 = 0.f;
    u32x4 gA0, gA1, gV; f32x4 gD;
    gV = (u32x4){0u, 0u, 0u, 0u};
    constexpr size_t CH = (size_t)TS * 512;
#define RW_LOAD(c) do { gA0 = *(const u32x4*)(srcA0 + (size_t)(c) * CH); gA1 = *(const u32x4*)(srcA1 + (size_t)(c) * CH); gD = *(const f32x4*)(srcD + (size_t)(c) * CH); \
        if (i < 32) gV = *(const u32x4*)(srcV + (size_t)(c) * CH); } while (0)
#define RW_WRITE(B) do { float f[8]; unpack8(gA0, f); *(LAS f32x4*)((B) + dA0) = (f32x4){f[0], f[1], f[2], f[3]}; *(LAS f32x4*)((B) + dA0 + 4) = (f32x4){f[4], f[5], f[6], f[7]}; \
        unpack8(gA1, f); *(LAS f32x4*)((B) + dA1) = (f32x4){f[0] * sg1, f[1] * sg1, f[2] * sg1, f[3] * sg1}; *(LAS f32x4*)((B) + dA1 + 4) = (f32x4){f[4] * sg1, f[5] * sg1, f[6] * sg1, f[7] * sg1}; \
        *(LAS f32x4*)((B) + dD) = gD; \
        if (i < 32) { unpack8(gV, f); *(LAS f32x4*)((B) + dV) = (f32x4){f[0], f[1], f[2], f[3]}; *(LAS f32x4*)((B) + dV + 4) = (f32x4){f[4], f[5], f[6], f[7]}; } } while (0)
    RW_LOAD(0); RW_WRITE(lds); WG_BAR();
    constexpr int NCH = TSEQ / TS;
    for (int c = 0; c < NCH; ++c) {
        if (c + 1 < NCH) RW_LOAD(c + 1);
        const LAS float* B = lds + (c & 1) * RW_BUF;
        float ykeep = 0.f;
#pragma unroll
        for (int st = 0; st < TS; ++st) {
            const LAS float* P = B + st * RW_STEP;
            const f32x4 rr = *(const LAS f32x4*)(P + kq * 4), ww = *(const LAS f32x4*)(P + 64 + kq * 4), kk = *(const LAS f32x4*)(P + 128 + kq * 4),
                        aa = *(const LAS f32x4*)(P + 192 + kq * 4), bb = *(const LAS f32x4*)(P + 256 + kq * 4);
            const float vv = P[320 + rl];
            float sa = S0 * aa[0] + S1 * aa[1] + S2 * aa[2] + S3 * aa[3];
            const float t0 = S0 * ww[0] + vv * kk[0], t1 = S1 * ww[1] + vv * kk[1], t2 = S2 * ww[2] + vv * kk[2], t3 = S3 * ww[3] + vv * kk[3];
            sa = red16(sa);
            S0 = sa * bb[0] + t0; S1 = sa * bb[1] + t1; S2 = sa * bb[2] + t2; S3 = sa * bb[3] + t3;
            float y = S0 * rr[0] + S1 * rr[1] + S2 * rr[2] + S3 * rr[3];
            y = red16(y);
            ykeep = (kq == st) ? y : ykeep;
        }
        { const unsigned short yb = (unsigned short)(pk2(ykeep, 0.f) & 0xffffu); Y[(mrow0 + (size_t)c * TS + kq) * 512 + colh + 16 * s + rl] = yb; }
        if (c + 1 < NCH) { LAS float* Bn = lds + ((c + 1) & 1) * RW_BUF; RW_WRITE(Bn); }
        WG_BAR();
    }
#undef RW_LOAD
#undef RW_WRITE
}

__device__ __forceinline__ void gdn_scan(LAS float* lds, const bf16* __restrict__ GQ, const bf16* __restrict__ GK, const bf16* __restrict__ GV,
                                         const float* __restrict__ ALPHA, const float* __restrict__ BETA, bf16* __restrict__ O, int tid, int lane, int wave) {
    const int pair = blockIdx.x >> 3, s = blockIdx.x & 7, b = pair >> 2, h = pair & 3;
    const size_t mrow0 = (size_t)b * TSEQ; const int colh = h * 128; const int i = tid - 256;
    const int q_step = i >> 4, q_seg = i & 15;
    const bf16* srcQ = GQ + (mrow0 + q_step) * 512 + colh + q_seg * 8;
    const bf16* srcK = GK + (mrow0 + q_step) * 512 + colh + q_seg * 8;
    const int v_step = (i >> 1) & 15, v_seg = i & 1;
    const bf16* srcV = GV + (mrow0 + v_step) * 512 + colh + 16 * s + v_seg * 8;
    const float* srcBv = BETA + (mrow0 + v_step) * 4 + h;
    const int s_step = i & 15;
    const float* srcAl = ALPHA + (mrow0 + s_step) * 4 + h; const float* srcBe = BETA + (mrow0 + s_step) * 4 + h;
    const int dQ = q_step * GD_STEP + q_seg * 8, dK = dQ + 128, dV = v_step * GD_STEP + 256 + v_seg * 8, dS = s_step * GD_STEP + 272;
    const int kq = lane & 15, rl = (wave - 4) * 4 + (lane >> 4);
    float S[8];
#pragma unroll
    for (int e = 0; e < 8; ++e) S[e] = 0.f;
    u32x4 gQ, gK, gV; float gBv = 0.f, gAl = 0.f, gBe = 0.f;
    gV = (u32x4){0u, 0u, 0u, 0u};
    constexpr size_t CH = (size_t)TS * 512; constexpr size_t CH4 = (size_t)TS * 4;
#define GD_LOAD(c) do { gQ = *(const u32x4*)(srcQ + (size_t)(c) * CH); gK = *(const u32x4*)(srcK + (size_t)(c) * CH); \
        if (i < 32) { gV = *(const u32x4*)(srcV + (size_t)(c) * CH); gBv = srcBv[(size_t)(c) * CH4]; } \
        else if (i < 48) { gAl = srcAl[(size_t)(c) * CH4]; gBe = srcBe[(size_t)(c) * CH4]; } } while (0)
#define GD_WRITE(B) do { float f[8]; unpack8(gQ, f); *(LAS f32x4*)((B) + dQ) = (f32x4){f[0], f[1], f[2], f[3]}; *(LAS f32x4*)((B) + dQ + 4) = (f32x4){f[4], f[5], f[6], f[7]}; \
        unpack8(gK, f); *(LAS f32x4*)((B) + dK) = (f32x4){f[0], f[1], f[2], f[3]}; *(LAS f32x4*)((B) + dK + 4) = (f32x4){f[4], f[5], f[6], f[7]}; \
        if (i < 32) { unpack8(gV, f); *(LAS f32x4*)((B) + dV) = (f32x4){f[0] * gBv, f[1] * gBv, f[2] * gBv, f[3] * gBv}; *(LAS f32x4*)((B) + dV + 4) = (f32x4){f[4] * gBv, f[5] * gBv, f[6] * gBv, f[7] * gBv}; } \
        else if (i < 48) { *(LAS f32x2*)((B) + dS) = (f32x2){gAl * gBe, gAl}; } } while (0)
    LAS float* base = lds + GD_LDS_OFF;
    GD_LOAD(0); GD_WRITE(base); WG_BAR();
    constexpr int NCH = TSEQ / TS;
    for (int c = 0; c < NCH; ++c) {
        if (c + 1 < NCH) GD_LOAD(c + 1);
        const LAS float* B = base + (c & 1) * GD_BUF;
        float okeep = 0.f;
#pragma unroll
        for (int st = 0; st < TS; ++st) {
            const LAS float* P = B + st * GD_STEP;
            const f32x4 q0 = *(const LAS f32x4*)(P + kq * 4), q1 = *(const LAS f32x4*)(P + 64 + kq * 4), k0 = *(const LAS f32x4*)(P + 128 + kq * 4), k1 = *(const LAS f32x4*)(P + 192 + kq * 4);
            const float bv = P[256 + rl]; const f32x2 sc = *(const LAS f32x2*)(P + 272);
            float sa = S[0] * k0[0] + S[1] * k0[1] + S[2] * k0[2] + S[3] * k0[3] + S[4] * k1[0] + S[5] * k1[1] + S[6] * k1[2] + S[7] * k1[3];
            float T[8];
#pragma unroll
            for (int e = 0; e < 8; ++e) T[e] = S[e] * sc[1];
            sa = red16(sa);
            const float cc = bv - sc[0] * sa;
            S[0] = T[0] + cc * k0[0]; S[1] = T[1] + cc * k0[1]; S[2] = T[2] + cc * k0[2]; S[3] = T[3] + cc * k0[3];
            S[4] = T[4] + cc * k1[0]; S[5] = T[5] + cc * k1[1]; S[6] = T[6] + cc * k1[2]; S[7] = T[7] + cc * k1[3];
            float o = S[0] * q0[0] + S[1] * q0[1] + S[2] * q0[2] + S[3] * q0[3] + S[4] * q1[0] + S[5] * q1[1] + S[6] * q1[2] + S[7] * q1[3];
            o = red16(o);
            okeep = (kq == st) ? o : okeep;
        }
        { const unsigned short ob = (unsigned short)(pk2(okeep, 0.f) & 0xffffu); O[(mrow0 + (size_t)c * TS + kq) * 512 + colh + 16 * s + rl] = ob; }
        if (c + 1 < NCH) { LAS float* Bn = base + ((c + 1) & 1) * GD_BUF; GD_WRITE(Bn); }
        WG_BAR();
    }
#undef GD_LOAD
#undef GD_WRITE
}

struct Args { const float* in[26]; float* out; unsigned char* ws; int never; int pad; };
enum { I_X = 0, I_N1G, I_WIN, I_MU, I_W0, I_W2, I_A0, I_A2, I_G2, I_KK, I_KA, I_RK, I_LNW, I_LNB, I_RPROJ, I_GCONV, I_ALOG, I_DTB, I_GNW, I_GPROJ, I_WOUT, I_N2G, I_FUP, I_FCONV, I_FDN, I_FING };

__global__ void __launch_bounds__(NWAVES * 64, 2) hybrid_fwd(Args args) {
    extern __shared__ __attribute__((aligned(16))) unsigned char lds_raw[];
    cg::grid_group grid = cg::this_grid();
    LAS unsigned char* lds = (LAS unsigned char*)lds_raw;
    const int tid = threadIdx.x, lane = tid & 63, wave = __builtin_amdgcn_readfirstlane(tid >> 6);
    const int G = gridDim.x, bx = blockIdx.x;
    const int gw = bx * NWAVES + wave, NGW = G * NWAVES;
    unsigned char* ws_top = args.ws; unsigned char* dob_top = (unsigned char*)args.out;
#define DECL_PTRS() \
    unsigned char* ws = ws_top; unsigned char* dob = dob_top; asm volatile("" : "+s"(ws), "+s"(dob)); \
    const float* x = args.in[I_X]; \
    bf16* WIN_T = (bf16*)(ws + WS_WIN); bf16* WPROJ_T = (bf16*)(ws + WS_WPROJ); bf16* WOUT_T = (bf16*)(ws + WS_WOUT); bf16* WLORA_T = (bf16*)(ws + WS_WLORA); \
    bf16* WUP_T = (bf16*)(ws + WS_WUP); bf16* WDN_T = (bf16*)(ws + WS_WDN); \
    bf16* XN = (bf16*)(ws + WS_XN); bf16* PR = (bf16*)(dob + DO_PR); bf16* PQ = (bf16*)(ws + WS_PQ); bf16* PZ = (bf16*)(ws + WS_PZ); bf16* PG = (bf16*)(ws + WS_PG); \
    bf16* Rb = (bf16*)(ws + WS_R); bf16* Kb = (bf16*)(ws + WS_K); bf16* Vb = (bf16*)(ws + WS_V); bf16* KKb = (bf16*)(ws + WS_KK); bf16* ALORA = (bf16*)(dob + DO_ALORA); \
    bf16* GQ = (bf16*)(ws + WS_GQ); bf16* GK = (bf16*)(ws + WS_GK); bf16* GV = (bf16*)(ws + WS_GV); \
    float* ALPHA = (float*)(ws + WS_ALPHA); float* BETA = (float*)(ws + WS_BETA); \
    float* DEC = (float*)(dob + DO_DEC); bf16* BPb = (bf16*)(ws + WS_BP); bf16* Gb = (bf16*)(ws + WS_G); \
    bf16* Yb = (bf16*)(dob + DO_Y); bf16* Ob = (bf16*)(dob + DO_O); \
    bf16* YAB = (bf16*)(ws + WS_YAB); bf16* MIX = (bf16*)(ws + WS_MIX); bf16* X2B = (bf16*)(ws + WS_X2B); \
    bf16* Hh = (bf16*)(ws + WS_H); bf16* ACT = (bf16*)(ws + WS_ACT); \
    float* RS2 = (float*)(ws + CTL_RS2); float* RS3 = (float*)(ws + CTL_RS3); \
    float* X2 = (float*)dob;
#define GRID_BAR() do { __syncthreads(); grid.sync(); } while (0)

    if (PHMASK & (1u << 0)) {
        DECL_PTRS();
        LAS float* scr = (LAS float*)(lds + wave * 8448);
        LAS float* WAB = (LAS float*)(lds + 73728);
        const float* w_in = args.in[I_WIN]; const float* g1 = args.in[I_N1G];
        for (int e = tid; e < 8192; e += 512) { const int k = e >> 3, j = e & 7; WAB[e] = g1[k] * w_in[(size_t)k * 5896 + 3840 + j]; }
        constexpr int IT_A = 16 * 120, IT_B = 16 * 64, IT_P = 8 * 32, IT_O = 16 * 32, NIT = IT_A + IT_B + 2 * IT_P + IT_O;
        for (int it = gw; it < NIT; it += NGW) {
            int r = it;
            if (r < IT_A) { const int kb = r / 120, nb = r % 120; tr_item(w_in, 5896, 32 * nb, 64 * kb, WIN_T, 1024, 32 * nb, g1, scr, lane); continue; } r -= IT_A;
            if (r < IT_B) { const int kb = r / 64, nb = r % 64; tr_item(w_in, 5896, 3848 + 32 * nb, 64 * kb, WIN_T, 1024, 3840 + 32 * nb, g1, scr, lane); continue; } r -= IT_B;
            if (r < IT_P) { const int kb = r / 32, nb = r % 32; tr_item(args.in[I_RPROJ], 1024, 32 * nb, 64 * kb, WPROJ_T, 512, 32 * nb, nullptr, scr, lane); continue; } r -= IT_P;
            if (r < IT_P) { const int kb = r / 32, nb = r % 32; tr_item(args.in[I_GPROJ], 1024, 32 * nb, 64 * kb, WPROJ_T, 512, 1024 + 32 * nb, nullptr, scr, lane); continue; } r -= IT_P;
            { const int kb = r / 32, nb = r % 32; tr_item(args.in[I_WOUT], 1024, 32 * nb, 64 * kb, WOUT_T, 1024, 32 * nb, nullptr, scr, lane); }
        }
        for (int e = bx * 512 + tid; e < 1536 * 256; e += G * 512) {
            const int n = e >> 8, k = e & 255, grp = n >> 9, c = n & 511; float v = 0.f;
            if (grp == 0 && k < 64) v = args.in[I_W2][k * 512 + c];
            else if (grp == 1 && k >= 64 && k < 128) v = args.in[I_A2][(k - 64) * 512 + c];
            else if (grp == 2 && k >= 128) v = args.in[I_G2][(k - 128) * 512 + c];
            WLORA_T[e] = (bf16)(pk2(v, 0.f) & 0xffffu);
        }
        __syncthreads();
        const float* a_log = args.in[I_ALOG]; const float* dtb = args.in[I_DTB];
        for (int m = gw; m < M_TOK; m += NGW) {
            const f32x4* xr = (const f32x4*)(x + (size_t)m * DM) + lane;
            f32x4 v[4]; float ss = 0.f;
#pragma unroll
            for (int j = 0; j < 4; ++j) { v[j] = xr[64 * j]; ss += (v[j][0] * v[j][0] + v[j][1] * v[j][1]) + (v[j][2] * v[j][2] + v[j][3] * v[j][3]); }
            const float rs = __frsqrt_rn(wave_sum(ss) * (1.0f / DM) + 1e-6f);
            float ab[8];
#pragma unroll
            for (int q = 0; q < 8; ++q) ab[q] = 0.f;
            unsigned long long* o8 = (unsigned long long*)(XN + (size_t)m * DM) + lane;
#pragma unroll
            for (int j = 0; j < 4; ++j) {
#pragma unroll
                for (int e = 0; e < 4; ++e) { const int k = 4 * lane + 256 * j + e; const f32x4 wa = *(const LAS f32x4*)(WAB + k * 8), wb = *(const LAS f32x4*)(WAB + k * 8 + 4); const float xv = v[j][e];
                    ab[0] += xv * wa[0]; ab[1] += xv * wa[1]; ab[2] += xv * wa[2]; ab[3] += xv * wa[3]; ab[4] += xv * wb[0]; ab[5] += xv * wb[1]; ab[6] += xv * wb[2]; ab[7] += xv * wb[3]; }
                o8[64 * j] = (unsigned long long)pk2(v[j][0] * rs, v[j][1] * rs) | ((unsigned long long)pk2(v[j][2] * rs, v[j][3] * rs) << 32);
            }
#pragma unroll
            for (int q = 0; q < 8; ++q) ab[q] = wave_sum(ab[q]) * rs;
            if (lane < 4) {
                const float araw = lane == 0 ? ab[0] : lane == 1 ? ab[1] : lane == 2 ? ab[2] : ab[3];
                const float braw = lane == 0 ? ab[4] : lane == 1 ? ab[5] : lane == 2 ? ab[6] : ab[7];
                const float z = araw + dtb[lane]; const float sp = z > 20.f ? z : log1pf(__expf(z));
                const float gg = -__expf(a_log[lane]) * sp;
                ALPHA[(size_t)m * 4 + lane] = __expf(gg); BETA[(size_t)m * 4 + lane] = sigmoidf_(braw);
            }
        }
    }
    GRID_BAR();
    if (PHMASK & (1u << 1)) {
        DECL_PTRS();
        pg8::Gemm g{XN, WIN_T, M_TOK, NP1, DM}; pg8::StaticOrder S; S.init(M_TOK, NP1, G, bx);
        EpiP1 E{PR, PQ, PZ, PG};
        pg8::gemm_phase<EpiP1, pg8::StaticOrder, true, true>(lds, g, S, E);
    }
    GRID_BAR();
    if (PHMASK & (1u << 2)) {
        DECL_PTRS();
        const float* mu = args.in[I_MU]; const float* k_k = args.in[I_KK]; const float* cw = args.in[I_GCONV];
        constexpr int NITEM = (M_TOK / 16) * 7;
        for (int it = gw; it < NITEM; it += NGW) {
            const int part = it % 7, run = it / 7; const size_t m0 = (size_t)run * 16; const bool bstart = (m0 % TSEQ) == 0;
            if (part < 3) {
                const int c = part * 512 + 8 * lane; float mu8[8], kk8[8], prev[8];
#pragma unroll
                for (int e = 0; e < 8; ++e) { mu8[e] = mu[c + e]; kk8[e] = part == 1 ? k_k[8 * lane + e] : 0.f; prev[e] = 0.f; }
                if (!bstart) unpack8(*(const u32x4*)(PR + (m0 - 1) * 1792 + c), prev);
                bf16* dst = part == 0 ? Rb : part == 1 ? Kb : Vb;
                for (int i = 0; i < 16; ++i) { const size_t m = m0 + i; float cur[8], ps[8]; unpack8(*(const u32x4*)(PR + m * 1792 + c), cur);
#pragma unroll
                    for (int e = 0; e < 8; ++e) { ps[e] = cur[e] + (prev[e] - cur[e]) * mu8[e]; prev[e] = cur[e]; }
                    *(u32x4*)(dst + m * 512 + 8 * lane) = pack8(ps);
                    if (part == 1) { float kv[8], ss = 0.f;
#pragma unroll
                        for (int e = 0; e < 8; ++e) { kv[e] = ps[e] * kk8[e]; ss += kv[e] * kv[e]; }
                        ss = red8(ss); const float rn = __frsqrt_rn(ss + 1e-6f);
#pragma unroll
                        for (int e = 0; e < 8; ++e) kv[e] *= rn;
                        *(u32x4*)(KKb + m * 512 + 8 * lane) = pack8(kv); } }
            } else if (part == 3) {
                const int c = 1536 + 4 * lane; float mu4[4], prev[4] = {0.f, 0.f, 0.f, 0.f};
#pragma unroll
                for (int e = 0; e < 4; ++e) mu4[e] = mu[c + e];
                if (!bstart) { const u32x2 u = *(const u32x2*)(PR + (m0 - 1) * 1792 + c); prev[0] = bf_lo(u.x); prev[1] = bf_hi(u.x); prev[2] = bf_lo(u.y); prev[3] = bf_hi(u.y); }
                for (int i = 0; i < 16; ++i) { const size_t m = m0 + i; const u32x2 u = *(const u32x2*)(PR + m * 1792 + c);
                    float cur[4] = {bf_lo(u.x), bf_hi(u.x), bf_lo(u.y), bf_hi(u.y)}, o[4];
#pragma unroll
                    for (int e = 0; e < 4; ++e) { const float ps = cur[e] + (prev[e] - cur[e]) * mu4[e]; prev[e] = cur[e];
                        float r_;
                        if (lane < 16) { const float xc = fminf(fmaxf(ps, -15.f), 15.f); const float t = __expf(2.f * xc); r_ = (t - 1.f) / (t + 1.f); }
                        else if (lane < 32) r_ = ps; else r_ = sigmoidf_(ps);
                        o[e] = r_; }
                    u32x2 w; w.x = pk2(o[0], o[1]); w.y = pk2(o[2], o[3]); *(u32x2*)(ALORA + m * 256 + 4 * lane) = w; }
            } else {
                const int pp = part - 4, c = pp * 512 + 8 * lane; float w0[8], w1[8], w2[8], w3[8], x3[8], x2[8], x1[8];
#pragma unroll
                for (int e = 0; e < 8; ++e) { w0[e] = cw[c + e]; w1[e] = cw[1536 + c + e]; w2[e] = cw[3072 + c + e]; w3[e] = cw[4608 + c + e]; x3[e] = 0.f; x2[e] = 0.f; x1[e] = 0.f; }
                if (!bstart) { unpack8(*(const u32x4*)(PQ + (m0 - 3) * 1536 + c), x3); unpack8(*(const u32x4*)(PQ + (m0 - 2) * 1536 + c), x2); unpack8(*(const u32x4*)(PQ + (m0 - 1) * 1536 + c), x1); }
                bf16* dst = pp == 0 ? GQ : pp == 1 ? GK : GV;
                for (int i = 0; i < 16; ++i) { const size_t m = m0 + i; float x0[8], sv[8], ss = 0.f; unpack8(*(const u32x4*)(PQ + m * 1536 + c), x0);
#pragma unroll
                    for (int e = 0; e < 8; ++e) { const float a = w0[e] * x3[e] + w1[e] * x2[e] + w2[e] * x1[e] + w3[e] * x0[e]; sv[e] = siluf_(a); ss += sv[e] * sv[e]; x3[e] = x2[e]; x2[e] = x1[e]; x1[e] = x0[e]; }
                    if (pp < 2) { ss = red16(ss); const float rn = __frsqrt_rn(ss + 1e-6f) * (pp == 0 ? 0.08838834764831845f : 1.0f);
#pragma unroll
                        for (int e = 0; e < 8; ++e) sv[e] *= rn; }
                    *(u32x4*)(dst + m * 512 + 8 * lane) = pack8(sv); }
            }
        }
    }
    GRID_BAR();
    if (PHMASK & (1u << 3)) {
        DECL_PTRS();
        int kl = 256; asm volatile("" : "+s"(kl));
        pg8::Gemm g{ALORA, WLORA_T, M_TOK, 1536, kl}; pg8::StaticOrder S; S.init(M_TOK, 1536, G, bx);
        EpiP3 E{DEC, Kb, KKb, BPb, Gb, args.in[I_W0], args.in[I_A0], args.in[I_KA]};
        pg8::gemm_phase<EpiP3, pg8::StaticOrder, true, true>(lds, g, S, E);
    }
    GRID_BAR();
    if (PHMASK & (1u << 4)) {
        DECL_PTRS();
        if (wave < 4) rwkv_scan((LAS float*)lds, Rb, Kb, KKb, BPb, DEC, Vb, Yb, tid, lane, wave);
        else gdn_scan((LAS float*)lds, GQ, GK, GV, ALPHA, BETA, Ob, tid, lane, wave);
    }
    GRID_BAR();
    if (PHMASK & (1u << 5)) {
        DECL_PTRS();
        LAS float* scr = (LAS float*)(lds + wave * 8448);
        constexpr int IT_U = 16 * 176, IT_D = 44 * 32;
        for (int it = gw; it < IT_U + IT_D; it += NGW) {
            if (it < IT_U) { const int kb = it / 176, nb = it % 176; const int n0 = 32 * nb; const int hn = n0 < FFH ? n0 : n0 - FFH;
                const int drow = 256 * (hn / 128) + (hn % 128) + (n0 < FFH ? 0 : 128);
                tr_item(args.in[I_FUP], FF2, n0, 64 * kb, WUP_T, 1024, drow, args.in[I_N2G], scr, lane); }
            else { const int r = it - IT_U; const int kb = r / 32, nb = r % 32; tr_item(args.in[I_FDN], 1024, 32 * nb, 64 * kb, WDN_T, FFH, 32 * nb, nullptr, scr, lane); }
        }
        const float* ln_w = args.in[I_LNW]; const float* ln_b = args.in[I_LNB]; const float* r_k = args.in[I_RK]; const float* gnw = args.in[I_GNW];
        const int c = 8 * lane; float lw[8], lb[8], rk[8], nw[8];
#pragma unroll
        for (int e = 0; e < 8; ++e) { lw[e] = ln_w[c + e]; lb[e] = ln_b[c + e]; rk[e] = r_k[c + e]; nw[e] = gnw[(c + e) & 127]; }
        for (int m = gw; m < M_TOK; m += NGW) {
            const size_t off = (size_t)m * 512 + c;
            float y[8], r[8], k[8], v[8], g[8], o[8];
            unpack8(*(const u32x4*)(Yb + off), y); unpack8(*(const u32x4*)(Rb + off), r); unpack8(*(const u32x4*)(Kb + off), k); unpack8(*(const u32x4*)(Vb + off), v); unpack8(*(const u32x4*)(Gb + off), g);
            float s = 0.f, bon = 0.f;
#pragma unroll
            for (int e = 0; e < 8; ++e) { s += y[e]; bon += r[e] * k[e] * rk[e]; }
            s = red8(s); bon = red8(bon); const float mean = s * (1.0f / 64.0f); float q = 0.f;
#pragma unroll
            for (int e = 0; e < 8; ++e) { y[e] -= mean; q += y[e] * y[e]; }
            q = red8(q); const float rstd = __frsqrt_rn(q * (1.0f / 64.0f) + 64e-5f);
#pragma unroll
            for (int e = 0; e < 8; ++e) o[e] = ((y[e] * rstd) * lw[e] + lb[e] + bon * v[e]) * g[e];
            *(u32x4*)(YAB + off) = pack8(o);
            float ov[8], z[8]; unpack8(*(const u32x4*)(Ob + off), ov); unpack8(*(const u32x4*)(PZ + off), z);
            float ms = 0.f;
#pragma unroll
            for (int e = 0; e < 8; ++e) ms += ov[e] * ov[e];
            ms = red16(ms); const float rn = __frsqrt_rn(ms * (1.0f / 128.0f) + 1e-6f);
#pragma unroll
            for (int e = 0; e < 8; ++e) o[e] = ov[e] * rn * nw[e] * siluf_(z[e]);
            *(u32x4*)(YAB + (size_t)M_TOK * 512 + off) = pack8(o);
        }
    }
    GRID_BAR();
    if (PHMASK & (1u << 6)) {
        DECL_PTRS();
        pg8::Gemm g{YAB, WPROJ_T, 2 * M_TOK, 2048, 512}; PairOrder S; S.init(G, bx);
        EpiP6 E{PG, MIX};
        pg8::gemm_phase<EpiP6, PairOrder, true, true>(lds, g, S, E);
    }
    GRID_BAR();
    if (PHMASK & (1u << 7)) {
        DECL_PTRS();
        pg8::Gemm g{MIX, WOUT_T, M_TOK, 1024, 1024}; pg8::StaticOrder S; S.init(M_TOK, 1024, G, bx);
        EpiRes E{x, X2, X2B, RS2, 0};
        pg8::gemm_phase<EpiRes, pg8::StaticOrder, true, true>(lds, g, S, E);
    }
    GRID_BAR();
    for (int hh = 0; hh < 2; ++hh) {
        const int roff = hh * 16384;
        if (PHMASK & (1u << 8)) {
        DECL_PTRS();
            pg8::Gemm g{X2B + (size_t)roff * 1024, WUP_T, 16384, FF2, 1024}; pg8::StaticOrder S; S.init(16384, FF2, G, bx);
            EpiP8 E{Hh, RS2, roff};
            pg8::gemm_phase<EpiP8, pg8::StaticOrder, true, true>(lds, g, S, E);
        }
        GRID_BAR();
        if (PHMASK & (1u << 9)) {
        DECL_PTRS();
            const float* fcw = args.in[I_FCONV];
            constexpr int NITEM = (16384 / 16) * 6;
            for (int it = gw; it < NITEM; it += NGW) {
                const int q = it % 6, run = it / 6; const int L = lane + 64 * q; if (L >= 352) continue;
                const int hu = 8 * L, j = L >> 4, cg_ = 256 * j + 8 * (L & 15), cu_ = cg_ + 128;
                float wg0[8], wg1[8], wg2[8], wu0[8], wu1[8], wu2[8], g1[8], g2[8], u1[8], u2[8];
#pragma unroll
                for (int e = 0; e < 8; ++e) { wg0[e] = fcw[hu + e]; wg1[e] = fcw[FF2 + hu + e]; wg2[e] = fcw[2 * FF2 + hu + e];
                    wu0[e] = fcw[FFH + hu + e]; wu1[e] = fcw[FF2 + FFH + hu + e]; wu2[e] = fcw[2 * FF2 + FFH + hu + e]; g1[e] = 0.f; g2[e] = 0.f; u1[e] = 0.f; u2[e] = 0.f; }
                const size_t l0 = (size_t)run * 16; const bool bstart = ((roff + l0) % TSEQ) == 0;
                if (!bstart) { unpack8(*(const u32x4*)(Hh + (l0 - 2) * FF2 + cg_), g2); unpack8(*(const u32x4*)(Hh + (l0 - 1) * FF2 + cg_), g1);
                               unpack8(*(const u32x4*)(Hh + (l0 - 2) * FF2 + cu_), u2); unpack8(*(const u32x4*)(Hh + (l0 - 1) * FF2 + cu_), u1); }
                for (int i = 0; i < 16; ++i) { const size_t l = l0 + i; float g0[8], u0[8], o[8];
                    unpack8(*(const u32x4*)(Hh + l * FF2 + cg_), g0); unpack8(*(const u32x4*)(Hh + l * FF2 + cu_), u0);
#pragma unroll
                    for (int e = 0; e < 8; ++e) { const float cgv = wg0[e] * g2[e] + wg1[e] * g1[e] + wg2[e] * g0[e]; const float cuv = wu0[e] * u2[e] + wu1[e] * u1[e] + wu2[e] * u0[e];
                        o[e] = siluf_(cgv) * cuv; g2[e] = g1[e]; g1[e] = g0[e]; u2[e] = u1[e]; u1[e] = u0[e]; }
                    *(u32x4*)(ACT + l * FFH + hu) = pack8(o); }
            }
        }
        GRID_BAR();
        if (PHMASK & (1u << 10)) {
        DECL_PTRS();
            pg8::Gemm g{ACT, WDN_T, 16384, 1024, FFH}; pg8::StaticOrder S; S.init(16384, 1024, G, bx);
            EpiRes E{X2, X2, nullptr, RS3, roff};
            pg8::gemm_phase<EpiRes, pg8::StaticOrder, true, true>(lds, g, S, E);
        }
        GRID_BAR();
    }
    if (PHMASK & (1u << 11)) {
        DECL_PTRS();
        const float* fg = args.in[I_FING];
        f32x4 gv[4];
#pragma unroll
        for (int j = 0; j < 4; ++j) gv[j] = *((const f32x4*)fg + lane + 64 * j);
        for (int m = gw; m < M_TOK; m += NGW) {
            const float rs = __frsqrt_rn(RS3[m] * (1.0f / DM) + 1e-6f);
            f32x4* xr = (f32x4*)(X2 + (size_t)m * DM) + lane;
#pragma unroll
            for (int j = 0; j < 4; ++j) { f32x4 v = xr[64 * j]; v = v * rs * gv[j]; xr[64 * j] = v; }
        }
    }
    if (args.never) grid.sync();
}

extern "C" void kernel_launch(void* const* d_in, const int* in_sizes, int n_in, void* d_out, int out_size, void* d_ws, size_t ws_size, hipStream_t stream) {
    static int grid = 0;
    if (grid == 0) {
        if (n_in != 26 || in_sizes[0] != M_TOK * DM || out_size != M_TOK * DM || ws_size < WS_NEED) {
            fprintf(stderr, "kernel_launch: unexpected problem (n_in %d, in0 %d, out %d, ws %zu); nothing launched\n", n_in, n_in > 0 ? in_sizes[0] : -1, out_size, ws_size); grid = -1; return; }
        int dev = 0, cus = 0, per_cu = 0;
        hipGetDevice(&dev); hipDeviceGetAttribute(&cus, hipDeviceAttributeMultiprocessorCount, dev);
        hipFuncSetAttribute((const void*)hybrid_fwd, hipFuncAttributeMaxDynamicSharedMemorySize, LDS_BYTES);
        hipOccupancyMaxActiveBlocksPerMultiprocessor(&per_cu, (const void*)hybrid_fwd, NWAVES * 64, LDS_BYTES);
        (void)hipGetLastError();
        if (per_cu < 1) per_cu = 1;
        grid = cus;
        if (grid != 256) fprintf(stderr, "kernel_launch: %d CUs (expected 256)\n", grid);
    }
    if (grid < 0) return;
    hipMemsetAsync((char*)d_ws + WS_CTL, 0, CTL_ZERO_BYTES, stream);
    Args a{};
    for (int i = 0; i < 26; ++i) a.in[i] = (const float*)d_in[i];
    a.out = (float*)d_out; a.ws = (unsigned char*)d_ws; a.never = 0; a.pad = 0;
    void* kargs[] = {&a};
    hipError_t e = hipLaunchCooperativeKernel((const void*)hybrid_fwd, dim3(grid), dim3(NWAVES * 64), kargs, LDS_BYTES, stream);
    if (e != hipSuccess) fprintf(stderr, "cooperative launch failed: %s (grid %d)\n", hipGetErrorString(e), grid);
}
```

```cpp
#include <hip/hip_runtime.h>
#include <hip/hip_cooperative_groups.h>
#include <cstdio>
#include <cstdint>
namespace cg = cooperative_groups;
namespace pg8 {
#define PG8_LAS __attribute__((address_space(3)))
typedef unsigned short bf16_t;
typedef short bf16x8 __attribute__((ext_vector_type(8)));
typedef float f32x4 __attribute__((ext_vector_type(4)));
typedef unsigned u32x4 __attribute__((ext_vector_type(4)));
constexpr int BM = 256, BK = 64, HALF = 128, HTB = HALF * BK * 2  , STAGE_BYTES = 8 * HTB, NXCD = 8, WGM = 8;

__host__ __device__ __forceinline__ int lds_byte(int r, int c) { const int st = (r >> 4) * 2 + (c >> 5), rr = r & 15, cc = c & 31, ob = rr * 64 + cc * 2; return st * 1024 + (ob ^ (((ob >> 9) & 1) << 5)); }
__host__ __device__ __forceinline__ void stage_rc(int b, int& R, int& C) { const int st = b / 1024, sb = b % 1024, swz = sb ^ (((sb >> 9) & 1) << 5); R = (st >> 1) * 16 + swz / 64; C = (st & 1) * 32 + (swz % 64) / 2; }
__host__ __device__ __forceinline__ int perm32(int rho) { const int n = rho >> 4, i = rho & 15; return 8 * (i >> 2) + 4 * n + (i & 3); }

struct Unit { int pm, pn; };
struct Gemm { const bf16_t* A; const bf16_t* Bt; int M, N, K; };

struct StaticOrder {
    int nM, nN, nwg, G, c;
    __host__ __device__ void init(int M, int N, int G_, int c_) { nM = M / BM; nN = N / BM; nwg = nM * nN; G = G_; c = c_; }
    __host__ __device__ bool next(int i, Unit& u) const {
        const long L = (long)i * G + c; if (L >= nwg) return false;
        int wgid = (int)L; { const int q = nwg / NXCD, r = nwg % NXCD, xcd = wgid % NXCD, off = wgid / NXCD; wgid = (xcd < r ? xcd * (q + 1) : r * (q + 1) + (xcd - r) * q) + off; }
        const int nig = WGM * nN, gid = wgid / nig, fm = gid * WGM, gsz = (nM - fm) < WGM ? (nM - fm) : WGM;
        u.pm = fm + ((wgid % nig) % gsz); u.pn = (wgid % nig) / gsz; return true;
    }
    __device__ __forceinline__ void a_ready(const Unit&) const {}
    __device__ __forceinline__ void done(const Unit&) const {}
};

__device__ __forceinline__ unsigned cvt_pk_bf16(float lo, float hi) { unsigned r; asm volatile("v_cvt_pk_bf16_f32 %0, %1, %2" : "=v"(r) : "v"(lo), "v"(hi)); return r; }
typedef float f32x2 __attribute__((ext_vector_type(2)));
template <class Epi, class Sched, bool ALIGN_EPI = false, bool SP2 = false>
__device__ __forceinline__ void gemm_phase(PG8_LAS unsigned char* lds, const Gemm g, const Sched& S, const Epi& E) {
    const int tid = threadIdx.x, wid = __builtin_amdgcn_readfirstlane(tid >> 6), lane = tid & 63, wr = wid >> 2, wc = wid & 3, fr = lane & 15, fq = lane >> 4;
    const int K = g.K, nt = K / BK;
    unsigned voffA[2], voffB[2];
#pragma unroll
    for (int i = 0; i < 2; ++i) { int R, C; stage_rc(tid * 16 + i * 8192, R, C); const int Rb = Epi::PERM ? ((R & ~31) + perm32(R & 31)) : R;
        voffA[i] = (unsigned)(R * K + C) * 2u; voffB[i] = (unsigned)(Rb * K + C) * 2u; }
    const size_t kstep = (size_t)(BK * 2);
    const size_t hstep = (size_t)HALF * K * 2;
    const size_t tstep = 2 * hstep;
    const unsigned ldsw = (unsigned)wid * 1024u;
    const int aoff = lds_byte(wr * 64 + fr, fq * 8), boff = lds_byte(wc * 32 + fr, fq * 8);
#define PG8_SA(b, h) (((b) * 2 + (h)) * HTB)
#define PG8_SB(b, h) ((4 + (b) * 2 + (h)) * HTB)
#define PG8_STAGE(bufoff, gbase, voff) do { _Pragma("unroll") for (int _i = 0; _i < 2; ++_i) \
        __builtin_amdgcn_global_load_lds((const unsigned*)((const char*)(gbase) + (voff)[_i]), (PG8_LAS unsigned*)(lds + (bufoff) + ldsw + _i * 8192), 16, 0, 0); } while (0)
#define PG8_LDA(dst, b, h) do { _Pragma("unroll") for (int m = 0; m < 4; ++m) _Pragma("unroll") for (int k = 0; k < 2; ++k) dst[m][k] = *(const PG8_LAS bf16x8*)(lds + PG8_SA(b, h) + aoff + m * 2048 + k * 1024); } while (0)
#define PG8_LDB(dst, b, h) do { _Pragma("unroll") for (int n = 0; n < 2; ++n) _Pragma("unroll") for (int k = 0; k < 2; ++k) dst[n][k] = *(const PG8_LAS bf16x8*)(lds + PG8_SB(b, h) + boff + n * 2048 + k * 1024); } while (0)
#define PG8_MMA(ai, bj, At, Bt) do { __builtin_amdgcn_s_setprio(1); _Pragma("unroll") for (int m = 0; m < 4; ++m) _Pragma("unroll") for (int n = 0; n < 2; ++n) _Pragma("unroll") for (int k = 0; k < 2; ++k) \
        acc[ai][bj][m][n] = __builtin_amdgcn_mfma_f32_16x16x32_bf16(Bt[n][k], At[m][k], acc[ai][bj][m][n], 0, 0, 0); __builtin_amdgcn_s_setprio(0); } while (0)
#define PG8_WAIT_V(n) asm volatile("s_waitcnt vmcnt(" #n ")" ::: "memory")
#define PG8_WAIT_L(n) asm volatile("s_waitcnt lgkmcnt(" #n ")" ::: "memory")
#define PG8_BAR __builtin_amdgcn_s_barrier()
#define PG8_SCHED __builtin_amdgcn_sched_barrier(0)
    Unit cur, nxt; int ui = 0;
    if (!S.next(0, cur)) return;
    f32x4 acc[2][2][4][2];
#pragma unroll
    for (int a = 0; a < 2; ++a)
#pragma unroll
        for (int b = 0; b < 2; ++b)
#pragma unroll
            for (int m = 0; m < 4; ++m)
#pragma unroll
                for (int n = 0; n < 2; ++n) acc[a][b][m][n] = (f32x4){0.f, 0.f, 0.f, 0.f};
    bf16x8 At[4][2], B0[2][2], B1[2][2];
    const char* cA = (const char*)g.A + (size_t)cur.pm * tstep; const char* cB = (const char*)g.Bt + (size_t)cur.pn * tstep;
    S.a_ready(cur);
    if constexpr (SP2) {
        PG8_STAGE(PG8_SB(0, 0), cB, voffB); PG8_STAGE(PG8_SB(0, 1), cB + hstep, voffB); PG8_STAGE(PG8_SA(0, 0), cA, voffA); PG8_STAGE(PG8_SA(0, 1), cA + hstep, voffA);
        if (wr == 1) PG8_BAR;
        PG8_WAIT_V(2); PG8_BAR;
        PG8_STAGE(PG8_SB(1, 0), cB + kstep, voffB); PG8_STAGE(PG8_SA(1, 0), cA + kstep, voffA); PG8_STAGE(PG8_SB(1, 1), cB + hstep + kstep, voffB);
        PG8_WAIT_V(6); PG8_BAR;
    } else {
        PG8_STAGE(PG8_SB(0, 0), cB, voffB); PG8_STAGE(PG8_SA(0, 0), cA, voffA); PG8_STAGE(PG8_SB(0, 1), cB + hstep, voffB); PG8_STAGE(PG8_SA(0, 1), cA + hstep, voffA);
        if (wr == 1) PG8_BAR;
        PG8_WAIT_V(4); PG8_BAR;
        PG8_STAGE(PG8_SB(1, 0), cB + kstep, voffB); PG8_STAGE(PG8_SA(1, 0), cA + kstep, voffA); PG8_STAGE(PG8_SB(1, 1), cB + hstep + kstep, voffB);
        PG8_WAIT_V(6); PG8_BAR;
    }
    for (;;) {
        const bool has_next = S.next(ui + 1, nxt);
        const char* nA = has_next ? (const char*)g.A + (size_t)nxt.pm * tstep : cA; const char* nB = has_next ? (const char*)g.Bt + (size_t)nxt.pn * tstep : cB;
        for (int t = 0; t < nt; t += 2) {
            const bool last = (t == nt - 2);
            const char* a1 = cA + (size_t)(t + 1) * kstep;
            const char* a2 = last ? nA : cA + (size_t)(t + 2) * kstep; const char* b2 = last ? nB : cB + (size_t)(t + 2) * kstep;
            const char* a3 = a2 + kstep; const char* b3 = b2 + kstep;
            if (last && has_next) S.a_ready(nxt);
            if constexpr (SP2) {
            PG8_LDB(B0, 0, 0); PG8_LDB(B1, 0, 1); PG8_SCHED; PG8_LDA(At, 0, 0); PG8_STAGE(PG8_SA(1, 1), a1 + hstep, voffA);
            PG8_WAIT_V(8); PG8_WAIT_L(0); PG8_BAR; PG8_MMA(0, 0, At, B0); PG8_MMA(0, 1, At, B1); PG8_BAR; PG8_SCHED;
            PG8_LDA(At, 0, 1); PG8_STAGE(PG8_SB(0, 0), b2, voffB); PG8_STAGE(PG8_SB(0, 1), b2 + hstep, voffB); PG8_STAGE(PG8_SA(0, 0), a2, voffA);
            PG8_WAIT_V(8); PG8_WAIT_L(0); PG8_BAR; PG8_MMA(1, 0, At, B0); PG8_MMA(1, 1, At, B1); PG8_BAR; PG8_SCHED;
            PG8_LDB(B0, 1, 0); PG8_LDB(B1, 1, 1); PG8_SCHED; PG8_LDA(At, 1, 0); PG8_STAGE(PG8_SA(0, 1), a2 + hstep, voffA);
            PG8_WAIT_V(8); PG8_WAIT_L(0); PG8_BAR; PG8_MMA(0, 0, At, B0); PG8_MMA(0, 1, At, B1); PG8_BAR; PG8_SCHED;
            PG8_LDA(At, 1, 1); PG8_STAGE(PG8_SB(1, 0), b3, voffB); PG8_STAGE(PG8_SB(1, 1), b3 + hstep, voffB); PG8_STAGE(PG8_SA(1, 0), a3, voffA);
            PG8_WAIT_V(8); PG8_WAIT_L(0); PG8_BAR; PG8_MMA(1, 0, At, B0); PG8_MMA(1, 1, At, B1); PG8_BAR; PG8_SCHED;
            } else {
            PG8_LDB(B0, 0, 0); PG8_SCHED; PG8_LDA(At, 0, 0); PG8_STAGE(PG8_SA(1, 1), a1 + hstep, voffA);
            PG8_WAIT_L(8); PG8_BAR; PG8_WAIT_L(0); PG8_MMA(0, 0, At, B0); PG8_BAR; PG8_SCHED;
            PG8_LDB(B1, 0, 1); PG8_STAGE(PG8_SB(0, 0), b2, voffB);
            PG8_BAR; PG8_WAIT_L(0); PG8_MMA(0, 1, At, B1); PG8_BAR;
            PG8_LDA(At, 0, 1); PG8_STAGE(PG8_SA(0, 0), a2, voffA);
            PG8_BAR; PG8_WAIT_L(0); PG8_MMA(1, 0, At, B0); PG8_BAR; PG8_SCHED;
            PG8_STAGE(PG8_SB(0, 1), b2 + hstep, voffB);
            PG8_WAIT_V(6); PG8_BAR; PG8_MMA(1, 1, At, B1); PG8_BAR;
            PG8_LDB(B0, 1, 0); PG8_SCHED; PG8_LDA(At, 1, 0); PG8_STAGE(PG8_SA(0, 1), a2 + hstep, voffA);
            PG8_WAIT_L(8); PG8_BAR; PG8_WAIT_L(0); PG8_MMA(0, 0, At, B0); PG8_BAR; PG8_SCHED;
            PG8_LDB(B1, 1, 1); PG8_STAGE(PG8_SB(1, 0), b3, voffB);
            PG8_BAR; PG8_WAIT_L(0); PG8_MMA(0, 1, At, B1); PG8_BAR;
            PG8_LDA(At, 1, 1); PG8_STAGE(PG8_SA(1, 0), a3, voffA);
            PG8_BAR; PG8_WAIT_L(0); PG8_MMA(1, 0, At, B0); PG8_BAR; PG8_SCHED;
            PG8_STAGE(PG8_SB(1, 1), b3 + hstep, voffB);
            PG8_WAIT_V(6); PG8_BAR; PG8_MMA(1, 1, At, B1); PG8_BAR;
            }
        }
        if constexpr (ALIGN_EPI) { if (wr == 0) PG8_BAR; }
        if constexpr (!Epi::AFTER_DRAIN) { E(acc, cur, wr, wc, fr, fq); S.done(cur); }
        if (!has_next) break;
#pragma unroll
        for (int a = 0; a < 2; ++a)
#pragma unroll
            for (int b = 0; b < 2; ++b)
#pragma unroll
                for (int m = 0; m < 4; ++m)
#pragma unroll
                    for (int n = 0; n < 2; ++n) acc[a][b][m][n] = (f32x4){0.f, 0.f, 0.f, 0.f};
        cur = nxt; cA = nA; cB = nB; ++ui;
        if constexpr (ALIGN_EPI) { if (wr == 1) PG8_BAR; }
    }
    PG8_WAIT_V(0);
    if constexpr (!ALIGN_EPI) { if (wr == 0) PG8_BAR; }
    PG8_BAR;
    if constexpr (Epi::AFTER_DRAIN) { E.fused(acc, cur, wr, wc, fr, fq, lds, wid, lane); S.done(cur); }
#undef PG8_SA
#undef PG8_SB
#undef PG8_STAGE
#undef PG8_LDA
#undef PG8_LDB
#undef PG8_MMA
#undef PG8_WAIT_V
#undef PG8_WAIT_L
#undef PG8_BAR
#undef PG8_SCHED
}
}

#define LAS __attribute__((address_space(3)))
typedef unsigned short bf16;
typedef unsigned u32x4 __attribute__((ext_vector_type(4)));
typedef unsigned u32x2 __attribute__((ext_vector_type(2)));
typedef float f32x4 __attribute__((ext_vector_type(4)));
typedef float f32x2 __attribute__((ext_vector_type(2)));

constexpr int NWAVES = 8;
constexpr int M_TOK = 32768, TSEQ = 4096, DM = 1024;
constexpr int NP1 = 5888;
constexpr int FFH = 2816, FF2 = 5632;
constexpr size_t MiB = 1u << 20;
constexpr size_t WS_CTL = 0, CTL_ZERO_BYTES = 1 * MiB;
constexpr size_t CTL_RS2 = 256 * 1024, CTL_RS3 = 384 * 1024;
constexpr size_t WS_WIN = 1 * MiB, WS_WPROJ = 13 * MiB, WS_WOUT = 15 * MiB, WS_WLORA = 17 * MiB;
constexpr size_t WS_PG = 18 * MiB, WS_PZ = 146 * MiB, WS_PQ = 178 * MiB, WS_XN = 274 * MiB;
constexpr size_t WS_GV = 338 * MiB, WS_R = 370 * MiB, WS_K = 402 * MiB, WS_V = 434 * MiB, WS_KK = 466 * MiB;
constexpr size_t WS_ALPHA = 498 * MiB, WS_BETA = 499 * MiB;
constexpr size_t WS_BP = 178 * MiB, WS_G = 210 * MiB, WS_WUP = 242 * MiB, WS_WDN = 253 * MiB;
constexpr size_t WS_GQ = 274 * MiB, WS_GK = 306 * MiB;
constexpr size_t WS_YAB = 274 * MiB, WS_MIX = 370 * MiB, WS_X2B = 434 * MiB;
constexpr size_t WS_H = 18 * MiB, WS_ACT = 274 * MiB;
constexpr size_t WS_NEED = 512 * MiB;
constexpr size_t DO_PR = 0, DO_ALORA = 112 * MiB, DO_DEC = 0, DO_Y = 64 * MiB, DO_O = 96 * MiB;

constexpr int LDS_BYTES = 147456;
#ifndef PHMASK
#define PHMASK 0xFFFFu
#endif

__device__ __forceinline__ float bf_lo(unsigned u) { return __uint_as_float(u << 16); }
__device__ __forceinline__ float bf_hi(unsigned u) { return __uint_as_float(u & 0xffff0000u); }
__device__ __forceinline__ unsigned pk2(float lo, float hi) { return pg8::cvt_pk_bf16(lo, hi); }
__device__ __forceinline__ void unpack8(const u32x4 u, float (&f)[8]) {
    f[0] = bf_lo(u.x); f[1] = bf_hi(u.x); f[2] = bf_lo(u.y); f[3] = bf_hi(u.y); f[4] = bf_lo(u.z); f[5] = bf_hi(u.z); f[6] = bf_lo(u.w); f[7] = bf_hi(u.w);
}
__device__ __forceinline__ u32x4 pack8(const float (&f)[8]) { u32x4 o; o.x = pk2(f[0], f[1]); o.y = pk2(f[2], f[3]); o.z = pk2(f[4], f[5]); o.w = pk2(f[6], f[7]); return o; }
__device__ __forceinline__ float sigmoidf_(float x) { return __builtin_amdgcn_rcpf(1.0f + __expf(-x)); }
__device__ __forceinline__ float siluf_(float x) { return x * sigmoidf_(x); }
#define LDS_WAIT() asm volatile("s_waitcnt lgkmcnt(0)" ::: "memory")
#define WG_BAR() do { asm volatile("s_waitcnt lgkmcnt(0)" ::: "memory"); __builtin_amdgcn_s_barrier(); asm volatile("" ::: "memory"); } while (0)

template <int CTRL> __device__ __forceinline__ float dppf(float x) {
    return __int_as_float(__builtin_amdgcn_update_dpp(0, __float_as_int(x), CTRL, 0xF, 0xF, true));
}
__device__ __forceinline__ float red16(float x) { x += dppf<0xB1>(x); x += dppf<0x4E>(x); x += dppf<0x141>(x); x += dppf<0x140>(x); return x; }
__device__ __forceinline__ float red8(float x) { x += dppf<0xB1>(x); x += dppf<0x4E>(x); x += dppf<0x141>(x); return x; }
__device__ __forceinline__ float wave_sum(float v) {
#pragma unroll
    for (int o = 1; o < 64; o <<= 1) v += __shfl_xor(v, o);
    return v;
}

#define GAS __attribute__((address_space(1)))
#define XB_TMO      128
#define XB_XCNT(j)  (256  + 64 * (j))
#define XB_XSUB(j)  (1280 + 64 * (j))
#define XB_XGEN(j)  (2304 + 64 * (j))
#define XB_TOP      3328
#define XB_TOPGEN   3392
#define XCD_BAR_WORDS 3456
#define XB_SPIN_CAP (1u << 18)

__device__ __forceinline__ unsigned xb_ld(unsigned* p)              { return __hip_atomic_load(p, __ATOMIC_RELAXED, __HIP_MEMORY_SCOPE_AGENT); }
__device__ __forceinline__ unsigned xb_add(unsigned* p, unsigned v) { return __hip_atomic_fetch_add(p, v, __ATOMIC_RELAXED, __HIP_MEMORY_SCOPE_AGENT); }
__device__ __forceinline__ unsigned xb_xcc_id() { return (unsigned)__builtin_amdgcn_s_getreg((3 << 11) | 20) & 0xFu; }
#define XB_SPIN(cond, bar) do { unsigned _sp = 0; while (cond) { __builtin_amdgcn_s_sleep(1); \
    if ((++_sp & 255u) == 0u) { if (xb_ld(&(bar)[XB_TMO])) break; if (_sp > XB_SPIN_CAP) { atomicAdd(&(bar)[XB_TMO], 1u); break; } } } } while (0)

struct XcdBarrier {
    unsigned* bar; unsigned x;
    volatile LAS unsigned* st;
};

__device__ __forceinline__ XcdBarrier xcd_barrier_post(unsigned* bar, volatile LAS unsigned* st) {
    XcdBarrier b; b.bar = bar; b.x = xb_xcc_id(); b.st = st;
    if (threadIdx.x == 0) (void)xb_add(&bar[XB_XCNT(b.x)], 1u);
    return b;
}
__device__ __forceinline__ void xcd_barrier_complete(unsigned* bar, unsigned x, unsigned& nloc, unsigned& nx) {
    const unsigned G = gridDim.x * gridDim.y * gridDim.z;
    unsigned sum, cnt, mine, sp = 0u;
    for (;;) {
        sum = 0u; cnt = 0u; mine = 0u;
#pragma unroll
        for (unsigned j = 0; j < 16; ++j) { const unsigned c = xb_ld(&bar[XB_XCNT(j)]); sum += c; cnt += (c > 0u) ? 1u : 0u; mine = (j == x) ? c : mine; }
        if (sum == G) break;
        __builtin_amdgcn_s_sleep(1);
        if ((++sp & 255u) == 0u) { if (xb_ld(&bar[XB_TMO])) break; if (sp > XB_SPIN_CAP) { atomicAdd(&bar[XB_TMO], 1u); break; } }
    }
    nloc = mine > 0u ? mine : 1u; nx = cnt > 0u ? cnt : 1u;
}

__device__ __forceinline__ void xcd_barrier(const XcdBarrier& b) {
    asm volatile("s_waitcnt vmcnt(0)" ::: "memory");
    __syncthreads();
    if (threadIdx.x == 0) {
        unsigned* bar = b.bar;
        __builtin_amdgcn_s_waitcnt(0);
        unsigned nloc = b.st[0], nx = b.st[1];
        const unsigned old = xb_add(&bar[XB_XSUB(b.x)], 1u);
        const unsigned gen = old / nloc;
        if (old + 1u == (gen + 1u) * nloc) {
            __builtin_amdgcn_fence(__ATOMIC_RELEASE, "agent");
            asm volatile("s_waitcnt vmcnt(0)" ::: "memory");
            const unsigned og = xb_add(&bar[XB_TOP], 1u);
            const unsigned tg = og / nx;
            if (og + 1u == (tg + 1u) * nx) xb_add(&bar[XB_TOPGEN], 1u);
            else XB_SPIN(xb_ld(&bar[XB_TOPGEN]) == tg, bar);
            __builtin_amdgcn_fence(__ATOMIC_ACQUIRE, "agent");
            xb_add(&bar[XB_XGEN(b.x)], 1u);
            asm volatile("s_waitcnt vmcnt(0)" ::: "memory");
        } else {
            XB_SPIN(xb_ld(&bar[XB_XGEN(b.x)]) == gen, bar);
            __builtin_amdgcn_fence(__ATOMIC_ACQUIRE, "agent");
            asm volatile("s_waitcnt vmcnt(0)" ::: "memory");
        }
    }
    __syncthreads();
}

__device__ __forceinline__ void tr_item(const float* __restrict__ W, int ldw, int src_col, int k0, bf16* __restrict__ WT, int ldk, int dst_row,
                                        const float* __restrict__ gain, LAS float* scr, int lane) {
#pragma unroll 8
    for (int i = 0; i < 32; ++i) { const int kk = 2 * i + (lane >> 5); float g = gain ? gain[k0 + kk] : 1.0f;
        scr[kk * 33 + (lane & 31)] = W[(size_t)(k0 + kk) * ldw + src_col + (lane & 31)] * g; }
    LDS_WAIT(); asm volatile("" ::: "memory");
    const int c = lane & 7;
#pragma unroll
    for (int j = 0; j < 4; ++j) { const int n = (lane >> 3) + 8 * j; const LAS float* s = scr + (8 * c) * 33 + n;
        u32x4 o; o.x = pk2(s[0 * 33], s[1 * 33]); o.y = pk2(s[2 * 33], s[3 * 33]); o.z = pk2(s[4 * 33], s[5 * 33]); o.w = pk2(s[6 * 33], s[7 * 33]);
        *(u32x4*)(WT + (size_t)(dst_row + n) * ldk + k0 + 8 * c) = o; }
    LDS_WAIT(); asm volatile("" ::: "memory");
}

struct EpiP1 {
    static constexpr bool PERM = true, AFTER_DRAIN = false;
    bf16 *PR, *PQ, *PZ, *PG;
    __device__ __forceinline__ void operator()(const pg8::f32x4 (&acc)[2][2][4][2], const pg8::Unit& u, int wr, int wc, int fr, int fq) const {
        bf16* base; int ld, ct; const int pn = u.pn;
        if (pn < 7) { base = PR; ld = 1792; ct = pn; } else if (pn < 13) { base = PQ; ld = 1536; ct = pn - 7; } else if (pn < 15) { base = PZ; ld = 512; ct = pn - 13; } else { base = PG; ld = 2048; ct = pn - 15; }
        const int row0 = u.pm * 256 + wr * 64 + fr, col0 = ct * 256 + wc * 32 + 8 * fq;
#pragma unroll
        for (int ai = 0; ai < 2; ++ai)
#pragma unroll
            for (int m = 0; m < 4; ++m) { bf16* rowp = base + (size_t)(row0 + ai * 128 + m * 16) * ld + col0;
#pragma unroll
                for (int bj = 0; bj < 2; ++bj) { const pg8::f32x4 v0 = acc[ai][bj][m][0], v1 = acc[ai][bj][m][1];
                    u32x4 w; w.x = pk2(v0[0], v0[1]); w.y = pk2(v0[2], v0[3]); w.z = pk2(v1[0], v1[1]); w.w = pk2(v1[2], v1[3]);
                    *(u32x4*)(rowp + bj * 128) = w; } }
    }
};
struct EpiP3 {
    static constexpr bool PERM = true, AFTER_DRAIN = false;
    float* DEC; bf16* K; const bf16* KK; bf16* BP; bf16* G; const float *w0, *a0, *k_a;
    __device__ __forceinline__ void operator()(const pg8::f32x4 (&acc)[2][2][4][2], const pg8::Unit& u, int wr, int wc, int fr, int fq) const {
        const int grp = u.pn >> 1;
        const int row0 = u.pm * 256 + wr * 64 + fr, col0 = (u.pn & 1) * 256 + wc * 32 + 8 * fq;
#pragma unroll
        for (int ai = 0; ai < 2; ++ai)
#pragma unroll
            for (int m = 0; m < 4; ++m) {
#pragma unroll
                for (int bj = 0; bj < 2; ++bj) {
                    const int col = col0 + bj * 128;
                    const size_t off = (size_t)(row0 + ai * 128 + m * 16) * 512 + col;
                    const pg8::f32x4 v0 = acc[ai][bj][m][0], v1 = acc[ai][bj][m][1];
                    float v[8] = {v0[0], v0[1], v0[2], v0[3], v1[0], v1[1], v1[2], v1[3]};
                    if (grp == 0) {
                        const f32x4 pa = *(const f32x4*)(w0 + col), pb = *(const f32x4*)(w0 + col + 4);
                        const float p0[8] = {pa[0], pa[1], pa[2], pa[3], pb[0], pb[1], pb[2], pb[3]};
                        float d[8];
#pragma unroll
                        for (int e = 0; e < 8; ++e) d[e] = __expf(-0.60653065971f * sigmoidf_(p0[e] + v[e]));
                        *(f32x4*)(DEC + off) = (f32x4){d[0], d[1], d[2], d[3]}; *(f32x4*)(DEC + off + 4) = (f32x4){d[4], d[5], d[6], d[7]};
                    } else if (grp == 1) {
                        const f32x4 pa = *(const f32x4*)(a0 + col), pb = *(const f32x4*)(a0 + col + 4), pc = *(const f32x4*)(k_a + col), pd = *(const f32x4*)(k_a + col + 4);
                        const float p0[8] = {pa[0], pa[1], pa[2], pa[3], pb[0], pb[1], pb[2], pb[3]}, p1[8] = {pc[0], pc[1], pc[2], pc[3], pd[0], pd[1], pd[2], pd[3]};
                        float kr[8], kkv[8], kp[8], bp[8];
                        unpack8(*(const u32x4*)(K + off), kr); unpack8(*(const u32x4*)(KK + off), kkv);
#pragma unroll
                        for (int e = 0; e < 8; ++e) { const float a = sigmoidf_(p0[e] + v[e]); kp[e] = kr[e] * (1.0f + (a - 1.0f) * p1[e]); bp[e] = kkv[e] * a; }
                        *(u32x4*)(K + off) = pack8(kp); *(u32x4*)(BP + off) = pack8(bp);
                    } else {
                        *(u32x4*)(G + off) = pack8(v);
                    }
                    asm volatile("" ::: "memory");
                }
            }
    }
};
struct EpiP6 {
    static constexpr bool PERM = true, AFTER_DRAIN = false;
    const bf16* PG; bf16* MIX;
    __device__ __forceinline__ void operator()(const pg8::f32x4 (&acc)[2][2][4][2], const pg8::Unit& u, int wr, int wc, int fr, int fq) const {
        const int which = u.pm >= 128 ? 1 : 0, pm = u.pm - 128 * which, pn = u.pn - 4 * which;
        const int row0 = pm * 256 + wr * 64 + fr, col0 = pn * 256 + wc * 32 + 8 * fq;
#pragma unroll
        for (int ai = 0; ai < 2; ++ai)
#pragma unroll
            for (int m = 0; m < 4; ++m) { const size_t r = (size_t)(row0 + ai * 128 + m * 16);
#pragma unroll
                for (int bj = 0; bj < 2; ++bj) { const int col = col0 + bj * 128;
                    const pg8::f32x4 v0 = acc[ai][bj][m][0], v1 = acc[ai][bj][m][1];
                    float v[8] = {v0[0], v0[1], v0[2], v0[3], v1[0], v1[1], v1[2], v1[3]}, g[8];
                    unpack8(*(const u32x4*)(PG + r * 2048 + which * 1024 + col), g);
#pragma unroll
                    for (int e = 0; e < 8; ++e) v[e] *= sigmoidf_(g[e]);
                    if (which) { float pv[8]; unpack8(*(const u32x4*)(MIX + r * 1024 + col), pv);
#pragma unroll
                        for (int e = 0; e < 8; ++e) v[e] += pv[e]; }
                    *(u32x4*)(MIX + r * 1024 + col) = pack8(v); } asm volatile("" ::: "memory"); }
    }
};
struct EpiRes {
    static constexpr bool PERM = true, AFTER_DRAIN = false;
    const float* BASE; float* OUT; bf16* OUTB; float* RSACC; int row_off;
    __device__ __forceinline__ void operator()(const pg8::f32x4 (&acc)[2][2][4][2], const pg8::Unit& u, int wr, int wc, int fr, int fq) const {
        const int row0 = row_off + u.pm * 256 + wr * 64 + fr, col0 = u.pn * 256 + wc * 32 + 8 * fq;
#pragma unroll
        for (int ai = 0; ai < 2; ++ai)
#pragma unroll
            for (int m = 0; m < 4; ++m) { const size_t r = (size_t)(row0 + ai * 128 + m * 16); float ss = 0.f;
#pragma unroll
                for (int bj = 0; bj < 2; ++bj) { const size_t off = r * 1024 + col0 + bj * 128;
                    const f32x4 b0 = *(const f32x4*)(BASE + off), b1 = *(const f32x4*)(BASE + off + 4);
                    const pg8::f32x4 v0 = acc[ai][bj][m][0], v1 = acc[ai][bj][m][1];
                    float v[8] = {v0[0] + b0[0], v0[1] + b0[1], v0[2] + b0[2], v0[3] + b0[3], v1[0] + b1[0], v1[1] + b1[1], v1[2] + b1[2], v1[3] + b1[3]};
#pragma unroll
                    for (int e = 0; e < 8; ++e) ss += v[e] * v[e];
                    *(f32x4*)(OUT + off) = (f32x4){v[0], v[1], v[2], v[3]}; *(f32x4*)(OUT + off + 4) = (f32x4){v[4], v[5], v[6], v[7]};
                    if (OUTB) *(u32x4*)(OUTB + off) = pack8(v); }
                ss += __shfl_xor(ss, 16); ss += __shfl_xor(ss, 32);
                if (fq == 0) atomicAdd(RSACC + r, ss); asm volatile("" ::: "memory"); }
    }
};
struct EpiP8 {
    static constexpr bool PERM = true, AFTER_DRAIN = false;
    bf16* H; const float* RSACC; int row_off;
    __device__ __forceinline__ void operator()(const pg8::f32x4 (&acc)[2][2][4][2], const pg8::Unit& u, int wr, int wc, int fr, int fq) const {
        const int row0 = u.pm * 256 + wr * 64 + fr, col0 = u.pn * 256 + wc * 32 + 8 * fq;
#pragma unroll
        for (int ai = 0; ai < 2; ++ai)
#pragma unroll
            for (int m = 0; m < 4; ++m) { const int r = row0 + ai * 128 + m * 16; const float rs = __frsqrt_rn(RSACC[row_off + r] * (1.0f / 1024.0f) + 1e-6f);
#pragma unroll
                for (int bj = 0; bj < 2; ++bj) { const pg8::f32x4 v0 = acc[ai][bj][m][0] * rs, v1 = acc[ai][bj][m][1] * rs;
                    u32x4 w; w.x = pk2(v0[0], v0[1]); w.y = pk2(v0[2], v0[3]); w.z = pk2(v1[0], v1[1]); w.w = pk2(v1[2], v1[3]);
                    *(u32x4*)(H + (size_t)r * FF2 + col0 + bj * 128) = w; } asm volatile("" ::: "memory"); }
    }
};
struct PairOrder {
    pg8::StaticOrder base;
    __device__ void init(int G, int c) { base.init(M_TOK, 1024, G, c); }
    __device__ bool next(int i, pg8::Unit& u) const { pg8::Unit b; if (!base.next(i >> 1, b)) return false; const int w = i & 1; u.pm = b.pm + 128 * w; u.pn = b.pn + 4 * w; return true; }
    __device__ __forceinline__ void a_ready(const pg8::Unit&) const {}
    __device__ __forceinline__ void done(const pg8::Unit&) const {}
};

constexpr int TS = 16;
constexpr int RW_STEP = 336, RW_BUF = TS * RW_STEP;
constexpr int GD_STEP = 276, GD_BUF = TS * GD_STEP;
constexpr int GD_LDS_OFF = 2 * RW_BUF;

__device__ __forceinline__ void rwkv_scan(LAS float* lds, const bf16* __restrict__ R, const bf16* __restrict__ Kp, const bf16* __restrict__ KK, const bf16* __restrict__ BP,
                                          const float* __restrict__ DEC, const bf16* __restrict__ V, bf16* __restrict__ Y, int tid, int lane, int wave) {
    const int pair = blockIdx.x >> 2, s = blockIdx.x & 3, b = pair >> 3, h = pair & 7;
    const size_t mrow0 = (size_t)b * TSEQ; const int colh = h * 64; const int i = tid;
    const int a_arr = i >> 7, a_step = (i & 127) >> 3, a_seg = i & 7;
    const bf16* srcA0 = (a_arr == 0 ? R : Kp) + (mrow0 + a_step) * 512 + colh + a_seg * 8;
    const bf16* srcA1 = (a_arr == 0 ? KK : BP) + (mrow0 + a_step) * 512 + colh + a_seg * 8;
    const int d_step = i >> 4, d_seg = i & 15;
    const float* srcD = DEC + (mrow0 + d_step) * 512 + colh + d_seg * 4;
    const int v_step = (i >> 1) & 15, v_seg = i & 1;
    const bf16* srcV = V + (mrow0 + v_step) * 512 + colh + 16 * s + v_seg * 8;
    const int dA0 = a_step * RW_STEP + (a_arr == 0 ? 0 : 128) + a_seg * 8;
    const int dA1 = a_step * RW_STEP + (a_arr == 0 ? 192 : 256) + a_seg * 8;
    const float sg1 = a_arr == 0 ? -1.0f : 1.0f;
    const int dD = d_step * RW_STEP + 64 + d_seg * 4, dV = v_step * RW_STEP + 320 + v_seg * 8;
    const int kq = lane & 15, rl = wave * 4 + (lane >> 4);
    float S0 = 0.f, S1 = 0.f, S2 = 0.f, S3 = 0.f;
    u32x4 gA0, gA1, gV; f32x4 gD;
    gV = (u32x4){0u, 0u, 0u, 0u};
    constexpr size_t CH = (size_t)TS * 512;
#define RW_LOAD(c) do { gA0 = *(const u32x4*)(srcA0 + (size_t)(c) * CH); gA1 = *(const u32x4*)(srcA1 + (size_t)(c) * CH); gD = *(const f32x4*)(srcD + (size_t)(c) * CH); \
        if (i < 32) gV = *(const u32x4*)(srcV + (size_t)(c) * CH); } while (0)
#define RW_WRITE(B) do { float f[8]; unpack8(gA0, f); *(LAS f32x4*)((B) + dA0) = (f32x4){f[0], f[1], f[2], f[3]}; *(LAS f32x4*)((B) + dA0 + 4) = (f32x4){f[4], f[5], f[6], f[7]}; \
        unpack8(gA1, f); *(LAS f32x4*)((B) + dA1) = (f32x4){f[0] * sg1, f[1] * sg1, f[2] * sg1, f[3] * sg1}; *(LAS f32x4*)((B) + dA1 + 4) = (f32x4){f[4] * sg1, f[5] * sg1, f[6] * sg1, f[7] * sg1}; \
        *(LAS f32x4*)((B) + dD) = gD; \
        if (i < 32) { unpack8(gV, f); *(LAS f32x4*)((B) + dV) = (f32x4){f[0], f[1], f[2], f[3]}; *(LAS f32x4*)((B) + dV + 4) = (f32x4){f[4], f[5], f[6], f[7]}; } } while (0)
    RW_LOAD(0); RW_WRITE(lds); WG_BAR();
    constexpr int NCH = TSEQ / TS;
    for (int c = 0; c < NCH; ++c) {
        if (c + 1 < NCH) RW_LOAD(c + 1);
        const LAS float* B = lds + (c & 1) * RW_BUF;
        float ykeep = 0.f;
#pragma unroll
        for (int st = 0; st < TS; ++st) {
            const LAS float* P = B + st * RW_STEP;
            const f32x4 rr = *(const LAS f32x4*)(P + kq * 4), ww = *(const LAS f32x4*)(P + 64 + kq * 4), kk = *(const LAS f32x4*)(P + 128 + kq * 4),
                        aa = *(const LAS f32x4*)(P + 192 + kq * 4), bb = *(const LAS f32x4*)(P + 256 + kq * 4);
            const float vv = P[320 + rl];
            float sa = S0 * aa[0] + S1 * aa[1] + S2 * aa[2] + S3 * aa[3];
            const float t0 = S0 * ww[0] + vv * kk[0], t1 = S1 * ww[1] + vv * kk[1], t2 = S2 * ww[2] + vv * kk[2], t3 = S3 * ww[3] + vv * kk[3];
            sa = red16(sa);
            S0 = sa * bb[0] + t0; S1 = sa * bb[1] + t1; S2 = sa * bb[2] + t2; S3 = sa * bb[3] + t3;
            float y = S0 * rr[0] + S1 * rr[1] + S2 * rr[2] + S3 * rr[3];
            y = red16(y);
            ykeep = (kq == st) ? y : ykeep;
        }
        { const unsigned short yb = (unsigned short)(pk2(ykeep, 0.f) & 0xffffu); Y[(mrow0 + (size_t)c * TS + kq) * 512 + colh + 16 * s + rl] = yb; }
        if (c + 1 < NCH) { LAS float* Bn = lds + ((c + 1) & 1) * RW_BUF; RW_WRITE(Bn); }
        WG_BAR();
    }
#undef RW_LOAD
#undef RW_WRITE
}

__device__ __forceinline__ void gdn_scan(LAS float* lds, const bf16* __restrict__ GQ, const bf16* __restrict__ GK, const bf16* __restrict__ GV,
                                         const float* __restrict__ ALPHA, const float* __restrict__ BETA, bf16* __restrict__ O, int tid, int lane, int wave) {
    const int pair = blockIdx.x >> 3, s = blockIdx.x & 7, b = pair >> 2, h = pair & 3;
    const size_t mrow0 = (size_t)b * TSEQ; const int colh = h * 128; const int i = tid - 256;
    const int q_step = i >> 4, q_seg = i & 15;
    const bf16* srcQ = GQ + (mrow0 + q_step) * 512 + colh + q_seg * 8;
    const bf16* srcK = GK + (mrow0 + q_step) * 512 + colh + q_seg * 8;
    const int v_step = (i >> 1) & 15, v_seg = i & 1;
    const bf16* srcV = GV + (mrow0 + v_step) * 512 + colh + 16 * s + v_seg * 8;
    const float* srcBv = BETA + (mrow0 + v_step) * 4 + h;
    const int s_step = i & 15;
    const float* srcAl = ALPHA + (mrow0 + s_step) * 4 + h; const float* srcBe = BETA + (mrow0 + s_step) * 4 + h;
    const int dQ = q_step * GD_STEP + q_seg * 8, dK = dQ + 128, dV = v_step * GD_STEP + 256 + v_seg * 8, dS = s_step * GD_STEP + 272;
    const int kq = lane & 15, rl = (wave - 4) * 4 + (lane >> 4);
    float S[8];
#pragma unroll
    for (int e = 0; e < 8; ++e) S[e] = 0.f;
    u32x4 gQ, gK, gV; float gBv = 0.f, gAl = 0.f, gBe = 0.f;
    gV = (u32x4){0u, 0u, 0u, 0u};
    constexpr size_t CH = (size_t)TS * 512; constexpr size_t CH4 = (size_t)TS * 4;
#define GD_LOAD(c) do { gQ = *(const u32x4*)(srcQ + (size_t)(c) * CH); gK = *(const u32x4*)(srcK + (size_t)(c) * CH); \
        if (i < 32) { gV = *(const u32x4*)(srcV + (size_t)(c) * CH); gBv = srcBv[(size_t)(c) * CH4]; } \
        else if (i < 48) { gAl = srcAl[(size_t)(c) * CH4]; gBe = srcBe[(size_t)(c) * CH4]; } } while (0)
#define GD_WRITE(B) do { float f[8]; unpack8(gQ, f); *(LAS f32x4*)((B) + dQ) = (f32x4){f[0], f[1], f[2], f[3]}; *(LAS f32x4*)((B) + dQ + 4) = (f32x4){f[4], f[5], f[6], f[7]}; \
        unpack8(gK, f); *(LAS f32x4*)((B) + dK) = (f32x4){f[0], f[1], f[2], f[3]}; *(LAS f32x4*)((B) + dK + 4) = (f32x4){f[4], f[5], f[6], f[7]}; \
        if (i < 32) { unpack8(gV, f); *(LAS f32x4*)((B) + dV) = (f32x4){f[0] * gBv, f[1] * gBv, f[2] * gBv, f[3] * gBv}; *(LAS f32x4*)((B) + dV + 4) = (f32x4){f[4] * gBv, f[5] * gBv, f[6] * gBv, f[7] * gBv}; } \
        else if (i < 48) { *(LAS f32x2*)((B) + dS) = (f32x2){gAl * gBe, gAl}; } } while (0)
    LAS float* base = lds + GD_LDS_OFF;
    GD_LOAD(0); GD_WRITE(base); WG_BAR();
    constexpr int NCH = TSEQ / TS;
    for (int c = 0; c < NCH; ++c) {
        if (c + 1 < NCH) GD_LOAD(c + 1);
        const LAS float* B = base + (c & 1) * GD_BUF;
        float okeep = 0.f;
#pragma unroll
        for (int st = 0; st < TS; ++st) {
            const LAS float* P = B + st * GD_STEP;
            const f32x4 q0 = *(const LAS f32x4*)(P + kq * 4), q1 = *(const LAS f32x4*)(P + 64 + kq * 4), k0 = *(const LAS f32x4*)(P + 128 + kq * 4), k1 = *(const LAS f32x4*)(P + 192 + kq * 4);
            const float bv = P[256 + rl]; const f32x2 sc = *(const LAS f32x2*)(P + 272);
            float sa = S[0] * k0[0] + S[1] * k0[1] + S[2] * k0[2] + S[3] * k0[3] + S[4] * k1[0] + S[5] * k1[1] + S[6] * k1[2] + S[7] * k1[3];
            float T[8];
#pragma unroll
            for (int e = 0; e < 8; ++e) T[e] = S[e] * sc[1];
            sa = red16(sa);
            const float cc = bv - sc[0] * sa;
            S[0] = T[0] + cc * k0[0]; S[1] = T[1] + cc * k0[1]; S[2] = T[2] + cc * k0[2]; S[3] = T[3] + cc * k0[3];
            S[4] = T[4] + cc * k1[0]; S[5] = T[5] + cc * k1[1]; S[6] = T[6] + cc * k1[2]; S[7] = T[7] + cc * k1[3];
            float o = S[0] * q0[0] + S[1] * q0[1] + S[2] * q0[2] + S[3] * q0[3] + S[4] * q1[0] + S[5] * q1[1] + S[6] * q1[2] + S[7] * q1[3];
            o = red16(o);
            okeep = (kq == st) ? o : okeep;
        }
        { const unsigned short ob = (unsigned short)(pk2(okeep, 0.f) & 0xffffu); O[(mrow0 + (size_t)c * TS + kq) * 512 + colh + 16 * s + rl] = ob; }
        if (c + 1 < NCH) { LAS float* Bn = base + ((c + 1) & 1) * GD_BUF; GD_WRITE(Bn); }
        WG_BAR();
    }
#undef GD_LOAD
#undef GD_WRITE
}

struct Args { const float* in[26]; float* out; unsigned char* ws; int never; int pad; };
enum { I_X = 0, I_N1G, I_WIN, I_MU, I_W0, I_W2, I_A0, I_A2, I_G2, I_KK, I_KA, I_RK, I_LNW, I_LNB, I_RPROJ, I_GCONV, I_ALOG, I_DTB, I_GNW, I_GPROJ, I_WOUT, I_N2G, I_FUP, I_FCONV, I_FDN, I_FING };

__global__ void __launch_bounds__(NWAVES * 64, 2) hybrid_fwd(Args args) {
    extern __shared__ __attribute__((aligned(16))) unsigned char lds_raw[];
    cg::grid_group grid = cg::this_grid();
    LAS unsigned char* lds = (LAS unsigned char*)lds_raw;
    const int tid = threadIdx.x, lane = tid & 63, wave = __builtin_amdgcn_readfirstlane(tid >> 6);
    const int G = gridDim.x, bx = blockIdx.x;
    const int gw = bx * NWAVES + wave, NGW = G * NWAVES;
    unsigned char* ws_top = args.ws; unsigned char* dob_top = (unsigned char*)args.out;
#define DECL_PTRS() \
    GAS unsigned char* wsg = (GAS unsigned char*)ws_top; GAS unsigned char* dobg = (GAS unsigned char*)dob_top; asm volatile("" : "+s"(wsg), "+s"(dobg)); \
    unsigned char* ws = (unsigned char*)wsg; unsigned char* dob = (unsigned char*)dobg; \
    const float* x = args.in[I_X]; \
    bf16* WIN_T = (bf16*)(ws + WS_WIN); bf16* WPROJ_T = (bf16*)(ws + WS_WPROJ); bf16* WOUT_T = (bf16*)(ws + WS_WOUT); bf16* WLORA_T = (bf16*)(ws + WS_WLORA); \
    bf16* WUP_T = (bf16*)(ws + WS_WUP); bf16* WDN_T = (bf16*)(ws + WS_WDN); \
    bf16* XN = (bf16*)(ws + WS_XN); bf16* PR = (bf16*)(dob + DO_PR); bf16* PQ = (bf16*)(ws + WS_PQ); bf16* PZ = (bf16*)(ws + WS_PZ); bf16* PG = (bf16*)(ws + WS_PG); \
    bf16* Rb = (bf16*)(ws + WS_R); bf16* Kb = (bf16*)(ws + WS_K); bf16* Vb = (bf16*)(ws + WS_V); bf16* KKb = (bf16*)(ws + WS_KK); bf16* ALORA = (bf16*)(dob + DO_ALORA); \
    bf16* GQ = (bf16*)(ws + WS_GQ); bf16* GK = (bf16*)(ws + WS_GK); bf16* GV = (bf16*)(ws + WS_GV); \
    float* ALPHA = (float*)(ws + WS_ALPHA); float* BETA = (float*)(ws + WS_BETA); \
    float* DEC = (float*)(dob + DO_DEC); bf16* BPb = (bf16*)(ws + WS_BP); bf16* Gb = (bf16*)(ws + WS_G); \
    bf16* Yb = (bf16*)(dob + DO_Y); bf16* Ob = (bf16*)(dob + DO_O); \
    bf16* YAB = (bf16*)(ws + WS_YAB); bf16* MIX = (bf16*)(ws + WS_MIX); bf16* X2B = (bf16*)(ws + WS_X2B); \
    bf16* Hh = (bf16*)(ws + WS_H); bf16* ACT = (bf16*)(ws + WS_ACT); \
    float* RS2 = (float*)(ws + CTL_RS2); float* RS3 = (float*)(ws + CTL_RS3); \
    float* X2 = (float*)dob;
    if (tid < 64) ((LAS unsigned*)(lds + 131072))[tid] = 0u;
    __syncthreads();
    XcdBarrier bar = xcd_barrier_post((unsigned*)(ws_top + 16384), (volatile LAS unsigned*)(lds + 131072 + 64));
    if (tid == 0) { unsigned nloc, nx; xcd_barrier_complete(bar.bar, bar.x, nloc, nx); bar.st[0] = nloc; bar.st[1] = nx; }
    __syncthreads();
#ifdef USE_CG
#define GRID_BAR() do { __syncthreads(); grid.sync(); } while (0)
#else
#define GRID_BAR() xcd_barrier(bar)
#endif

    if (PHMASK & (1u << 0)) {
        DECL_PTRS();
        LAS float* scr = (LAS float*)(lds + wave * 8448);
        LAS float* WAB = (LAS float*)(lds + 73728);
        const float* w_in = args.in[I_WIN]; const float* g1 = args.in[I_N1G];
        for (int e = tid; e < 8192; e += 512) { const int k = e >> 3, j = e & 7; WAB[e] = g1[k] * w_in[(size_t)k * 5896 + 3840 + j]; }
        constexpr int IT_A = 16 * 120, IT_B = 16 * 64, IT_P = 8 * 32, IT_O = 16 * 32, NIT = IT_A + IT_B + 2 * IT_P + IT_O;
        for (int it = gw; it < NIT; it += NGW) {
            int r = it;
            if (r < IT_A) { const int kb = r / 120, nb = r % 120; tr_item(w_in, 5896, 32 * nb, 64 * kb, WIN_T, 1024, 32 * nb, g1, scr, lane); continue; } r -= IT_A;
            if (r < IT_B) { const int kb = r / 64, nb = r % 64; tr_item(w_in, 5896, 3848 + 32 * nb, 64 * kb, WIN_T, 1024, 3840 + 32 * nb, g1, scr, lane); continue; } r -= IT_B;
            if (r < IT_P) { const int kb = r / 32, nb = r % 32; tr_item(args.in[I_RPROJ], 1024, 32 * nb, 64 * kb, WPROJ_T, 512, 32 * nb, nullptr, scr, lane); continue; } r -= IT_P;
            if (r < IT_P) { const int kb = r / 32, nb = r % 32; tr_item(args.in[I_GPROJ], 1024, 32 * nb, 64 * kb, WPROJ_T, 512, 1024 + 32 * nb, nullptr, scr, lane); continue; } r -= IT_P;
            { const int kb = r / 32, nb = r % 32; tr_item(args.in[I_WOUT], 1024, 32 * nb, 64 * kb, WOUT_T, 1024, 32 * nb, nullptr, scr, lane); }
        }
        for (int e = bx * 512 + tid; e < 1536 * 256; e += G * 512) {
            const int n = e >> 8, k = e & 255, grp = n >> 9, c = n & 511; float v = 0.f;
            if (grp == 0 && k < 64) v = args.in[I_W2][k * 512 + c];
            else if (grp == 1 && k >= 64 && k < 128) v = args.in[I_A2][(k - 64) * 512 + c];
            else if (grp == 2 && k >= 128) v = args.in[I_G2][(k - 128) * 512 + c];
            WLORA_T[e] = (bf16)(pk2(v, 0.f) & 0xffffu);
        }
        __syncthreads();
        const float* a_log = args.in[I_ALOG]; const float* dtb = args.in[I_DTB];
        for (int m = gw; m < M_TOK; m += NGW) {
            const f32x4* xr = (const f32x4*)(x + (size_t)m * DM) + lane;
            f32x4 v[4]; float ss = 0.f;
#pragma unroll
            for (int j = 0; j < 4; ++j) { v[j] = xr[64 * j]; ss += (v[j][0] * v[j][0] + v[j][1] * v[j][1]) + (v[j][2] * v[j][2] + v[j][3] * v[j][3]); }
            const float rs = __frsqrt_rn(wave_sum(ss) * (1.0f / DM) + 1e-6f);
            float ab[8];
#pragma unroll
            for (int q = 0; q < 8; ++q) ab[q] = 0.f;
            unsigned long long* o8 = (unsigned long long*)(XN + (size_t)m * DM) + lane;
#pragma unroll
            for (int j = 0; j < 4; ++j) {
#pragma unroll
                for (int e = 0; e < 4; ++e) { const int k = 4 * lane + 256 * j + e; const f32x4 wa = *(const LAS f32x4*)(WAB + k * 8), wb = *(const LAS f32x4*)(WAB + k * 8 + 4); const float xv = v[j][e];
                    ab[0] += xv * wa[0]; ab[1] += xv * wa[1]; ab[2] += xv * wa[2]; ab[3] += xv * wa[3]; ab[4] += xv * wb[0]; ab[5] += xv * wb[1]; ab[6] += xv * wb[2]; ab[7] += xv * wb[3]; }
                o8[64 * j] = (unsigned long long)pk2(v[j][0] * rs, v[j][1] * rs) | ((unsigned long long)pk2(v[j][2] * rs, v[j][3] * rs) << 32);
            }
#pragma unroll
            for (int q = 0; q < 8; ++q) ab[q] = wave_sum(ab[q]) * rs;
            if (lane < 4) {
                const float araw = lane == 0 ? ab[0] : lane == 1 ? ab[1] : lane == 2 ? ab[2] : ab[3];
                const float braw = lane == 0 ? ab[4] : lane == 1 ? ab[5] : lane == 2 ? ab[6] : ab[7];
                const float z = araw + dtb[lane]; const float sp = z > 20.f ? z : log1pf(__expf(z));
                const float gg = -__expf(a_log[lane]) * sp;
                ALPHA[(size_t)m * 4 + lane] = __expf(gg); BETA[(size_t)m * 4 + lane] = sigmoidf_(braw);
            }
        }
    }
    GRID_BAR();
    if (PHMASK & (1u << 1)) {
        DECL_PTRS();
        int kq_ = DM; asm volatile("" : "+s"(kq_));
        pg8::Gemm g{XN, WIN_T, M_TOK, NP1, kq_}; pg8::StaticOrder S; S.init(M_TOK, NP1, G, bx);
        EpiP1 E{PR, PQ, PZ, PG};
        pg8::gemm_phase<EpiP1, pg8::StaticOrder, true, true>(lds, g, S, E);
    }
    GRID_BAR();
    if (PHMASK & (1u << 2)) {
        DECL_PTRS();
        const float* mu = args.in[I_MU]; const float* k_k = args.in[I_KK]; const float* cw = args.in[I_GCONV];
        constexpr int NITEM = (M_TOK / 16) * 7;
        for (int it = gw; it < NITEM; it += NGW) {
            const int part = it % 7, run = it / 7; const size_t m0 = (size_t)run * 16; const bool bstart = (m0 % TSEQ) == 0;
            if (part < 3) {
                const int c = part * 512 + 8 * lane; float mu8[8], kk8[8], prev[8];
                u32x4 raw[16];
                { const bf16* pl = PR + m0 * 1792 + c; asm volatile("" : "+v"(pl));
#pragma unroll
                for (int i = 0; i < 16; ++i) raw[i] = *(const u32x4*)(pl + i * 1792); }
#pragma unroll
                for (int e = 0; e < 8; ++e) { mu8[e] = mu[c + e]; kk8[e] = part == 1 ? k_k[8 * lane + e] : 0.f; prev[e] = 0.f; }
                if (!bstart) unpack8(*(const u32x4*)(PR + (m0 - 1) * 1792 + c), prev);
                bf16* dst = (part == 0 ? Rb : part == 1 ? Kb : Vb) + m0 * 512 + 8 * lane; bf16* dkk = KKb + m0 * 512 + 8 * lane; asm volatile("" : "+v"(dst), "+v"(dkk));
#pragma unroll
                for (int i = 0; i < 16; ++i) { float cur[8], ps[8]; unpack8(raw[i], cur);
#pragma unroll
                    for (int e = 0; e < 8; ++e) { ps[e] = cur[e] + (prev[e] - cur[e]) * mu8[e]; prev[e] = cur[e]; }
                    *(u32x4*)(dst + i * 512) = pack8(ps);
                    if (part == 1) { float kv[8], ss = 0.f;
#pragma unroll
                        for (int e = 0; e < 8; ++e) { kv[e] = ps[e] * kk8[e]; ss += kv[e] * kv[e]; }
                        ss = red8(ss); const float rn = __frsqrt_rn(ss + 1e-6f);
#pragma unroll
                        for (int e = 0; e < 8; ++e) kv[e] *= rn;
                        *(u32x4*)(dkk + i * 512) = pack8(kv); } }
            } else if (part == 3) {
                const int c = 1536 + 4 * lane; float mu4[4], prev[4] = {0.f, 0.f, 0.f, 0.f};
                u32x2 raw[16];
                { const bf16* pl = PR + m0 * 1792 + c; asm volatile("" : "+v"(pl));
#pragma unroll
                for (int i = 0; i < 16; ++i) raw[i] = *(const u32x2*)(pl + i * 1792); }
#pragma unroll
                for (int e = 0; e < 4; ++e) mu4[e] = mu[c + e];
                if (!bstart) { const u32x2 u = *(const u32x2*)(PR + (m0 - 1) * 1792 + c); prev[0] = bf_lo(u.x); prev[1] = bf_hi(u.x); prev[2] = bf_lo(u.y); prev[3] = bf_hi(u.y); }
                bf16* dal = ALORA + m0 * 256 + 4 * lane; asm volatile("" : "+v"(dal));
#pragma unroll
                for (int i = 0; i < 16; ++i) { const u32x2 u = raw[i];
                    float cur[4] = {bf_lo(u.x), bf_hi(u.x), bf_lo(u.y), bf_hi(u.y)}, o[4];
#pragma unroll
                    for (int e = 0; e < 4; ++e) { const float ps = cur[e] + (prev[e] - cur[e]) * mu4[e]; prev[e] = cur[e];
                        const float xc = fminf(fmaxf(ps, -15.f), 15.f); const float t = __expf(2.f * xc); const float th = (t - 1.f) * __builtin_amdgcn_rcpf(t + 1.f);
                        const float sg = sigmoidf_(ps);
                        o[e] = lane < 16 ? th : (lane < 32 ? ps : sg); }
                    u32x2 w; w.x = pk2(o[0], o[1]); w.y = pk2(o[2], o[3]); *(u32x2*)(dal + i * 256) = w; }
            } else {
                const int pp = part - 4, c = pp * 512 + 8 * lane; float w0[8], w1[8], w2[8], w3[8], x3[8], x2[8], x1[8];
                u32x4 raw[16];
                { const bf16* pl = PQ + m0 * 1536 + c; asm volatile("" : "+v"(pl));
#pragma unroll
                for (int i = 0; i < 16; ++i) raw[i] = *(const u32x4*)(pl + i * 1536); }
#pragma unroll
                for (int e = 0; e < 8; ++e) { w0[e] = cw[c + e]; w1[e] = cw[1536 + c + e]; w2[e] = cw[3072 + c + e]; w3[e] = cw[4608 + c + e]; x3[e] = 0.f; x2[e] = 0.f; x1[e] = 0.f; }
                if (!bstart) { unpack8(*(const u32x4*)(PQ + (m0 - 3) * 1536 + c), x3); unpack8(*(const u32x4*)(PQ + (m0 - 2) * 1536 + c), x2); unpack8(*(const u32x4*)(PQ + (m0 - 1) * 1536 + c), x1); }
                bf16* dst = (pp == 0 ? GQ : pp == 1 ? GK : GV) + m0 * 512 + 8 * lane; asm volatile("" : "+v"(dst));
#pragma unroll
                for (int i = 0; i < 16; ++i) { float x0[8], sv[8], ss = 0.f; unpack8(raw[i], x0);
#pragma unroll
                    for (int e = 0; e < 8; ++e) { const float a = w0[e] * x3[e] + w1[e] * x2[e] + w2[e] * x1[e] + w3[e] * x0[e]; sv[e] = siluf_(a); ss += sv[e] * sv[e]; x3[e] = x2[e]; x2[e] = x1[e]; x1[e] = x0[e]; }
                    if (pp < 2) { ss = red16(ss); const float rn = __frsqrt_rn(ss + 1e-6f) * (pp == 0 ? 0.08838834764831845f : 1.0f);
#pragma unroll
                        for (int e = 0; e < 8; ++e) sv[e] *= rn; }
                    *(u32x4*)(dst + i * 512) = pack8(sv); }
            }
        }
    }
    GRID_BAR();
    if (PHMASK & (1u << 3)) {
        DECL_PTRS();
        int kl = 256; asm volatile("" : "+s"(kl));
        pg8::Gemm g{ALORA, WLORA_T, M_TOK, 1536, kl}; pg8::StaticOrder S; S.init(M_TOK, 1536, G, bx);
        EpiP3 E{DEC, Kb, KKb, BPb, Gb, args.in[I_W0], args.in[I_A0], args.in[I_KA]};
        pg8::gemm_phase<EpiP3, pg8::StaticOrder, true, true>(lds, g, S, E);
    }
    GRID_BAR();
    if (PHMASK & (1u << 4)) {
        DECL_PTRS();
        if (wave < 4) rwkv_scan((LAS float*)lds, Rb, Kb, KKb, BPb, DEC, Vb, Yb, tid, lane, wave);
        else gdn_scan((LAS float*)lds, GQ, GK, GV, ALPHA, BETA, Ob, tid, lane, wave);
    }
    GRID_BAR();
    if (PHMASK & (1u << 5)) {
        DECL_PTRS();
        LAS float* scr = (LAS float*)(lds + wave * 8448);
        constexpr int IT_U = 16 * 176, IT_D = 44 * 32;
        for (int it = gw; it < IT_U + IT_D; it += NGW) {
            if (it < IT_U) { const int kb = it / 176, nb = it % 176; const int n0 = 32 * nb; const int hn = n0 < FFH ? n0 : n0 - FFH;
                const int drow = 256 * (hn / 128) + (hn % 128) + (n0 < FFH ? 0 : 128);
                tr_item(args.in[I_FUP], FF2, n0, 64 * kb, WUP_T, 1024, drow, args.in[I_N2G], scr, lane); }
            else { const int r = it - IT_U; const int kb = r / 32, nb = r % 32; tr_item(args.in[I_FDN], 1024, 32 * nb, 64 * kb, WDN_T, FFH, 32 * nb, nullptr, scr, lane); }
        }
        const float* ln_w = args.in[I_LNW]; const float* ln_b = args.in[I_LNB]; const float* r_k = args.in[I_RK]; const float* gnw = args.in[I_GNW];
        const int c = 8 * lane; float lw[8], lb[8], rk[8], nw[8];
#pragma unroll
        for (int e = 0; e < 8; ++e) { lw[e] = ln_w[c + e]; lb[e] = ln_b[c + e]; rk[e] = r_k[c + e]; nw[e] = gnw[(c + e) & 127]; }
        for (int m = gw; m < M_TOK; m += NGW) {
            const size_t off = (size_t)m * 512 + c;
            float y[8], r[8], k[8], v[8], g[8], o[8];
            unpack8(*(const u32x4*)(Yb + off), y); unpack8(*(const u32x4*)(Rb + off), r); unpack8(*(const u32x4*)(Kb + off), k); unpack8(*(const u32x4*)(Vb + off), v); unpack8(*(const u32x4*)(Gb + off), g);
            float s = 0.f, bon = 0.f;
#pragma unroll
            for (int e = 0; e < 8; ++e) { s += y[e]; bon += r[e] * k[e] * rk[e]; }
            s = red8(s); bon = red8(bon); const float mean = s * (1.0f / 64.0f); float q = 0.f;
#pragma unroll
            for (int e = 0; e < 8; ++e) { y[e] -= mean; q += y[e] * y[e]; }
            q = red8(q); const float rstd = __frsqrt_rn(q * (1.0f / 64.0f) + 64e-5f);
#pragma unroll
            for (int e = 0; e < 8; ++e) o[e] = ((y[e] * rstd) * lw[e] + lb[e] + bon * v[e]) * g[e];
            *(u32x4*)(YAB + off) = pack8(o);
            float ov[8], z[8]; unpack8(*(const u32x4*)(Ob + off), ov); unpack8(*(const u32x4*)(PZ + off), z);
            float ms = 0.f;
#pragma unroll
            for (int e = 0; e < 8; ++e) ms += ov[e] * ov[e];
            ms = red16(ms); const float rn = __frsqrt_rn(ms * (1.0f / 128.0f) + 1e-6f);
#pragma unroll
            for (int e = 0; e < 8; ++e) o[e] = ov[e] * rn * nw[e] * siluf_(z[e]);
            *(u32x4*)(YAB + (size_t)M_TOK * 512 + off) = pack8(o);
        }
    }
    GRID_BAR();
    if (PHMASK & (1u << 6)) {
        DECL_PTRS();
        int kq_ = 512; asm volatile("" : "+s"(kq_));
        pg8::Gemm g{YAB, WPROJ_T, 2 * M_TOK, 2048, kq_}; PairOrder S; S.init(G, bx);
        EpiP6 E{PG, MIX};
        pg8::gemm_phase<EpiP6, PairOrder, true, true>(lds, g, S, E);
    }
    GRID_BAR();
    if (PHMASK & (1u << 7)) {
        DECL_PTRS();
        int kq_ = 1024; asm volatile("" : "+s"(kq_));
        pg8::Gemm g{MIX, WOUT_T, M_TOK, 1024, kq_}; pg8::StaticOrder S; S.init(M_TOK, 1024, G, bx);
        EpiRes E{x, X2, X2B, RS2, 0};
        pg8::gemm_phase<EpiRes, pg8::StaticOrder, true, true>(lds, g, S, E);
    }
    GRID_BAR();
#pragma unroll 1
    for (int hh = 0; hh < 2; ++hh) {
        const int roff = hh * 16384;
        if (PHMASK & (1u << 8)) {
        DECL_PTRS();
            int kq_ = 1024; asm volatile("" : "+s"(kq_));
        pg8::Gemm g{X2B + (size_t)roff * 1024, WUP_T, 16384, FF2, kq_}; pg8::StaticOrder S; S.init(16384, FF2, G, bx);
            EpiP8 E{Hh, RS2, roff};
            pg8::gemm_phase<EpiP8, pg8::StaticOrder, true, true>(lds, g, S, E);
        }
        GRID_BAR();
            if (PHMASK & (1u << 9)) {
        DECL_PTRS();
            const float* fcw = args.in[I_FCONV];
            constexpr int NITEM = (16384 / 16) * 6;
            for (int it = gw; it < NITEM; it += NGW) {
                const int q = it % 6, run = it / 6; const int L = lane + 64 * q; if (L >= 352) continue;
                const int hu = 8 * L, j = L >> 4, cg_ = 256 * j + 8 * (L & 15), cu_ = cg_ + 128;
                float wg0[8], wg1[8], wg2[8], wu0[8], wu1[8], wu2[8], g1[8], g2[8], u1[8], u2[8];
#pragma unroll
                for (int e = 0; e < 8; ++e) { wg0[e] = fcw[hu + e]; wg1[e] = fcw[FF2 + hu + e]; wg2[e] = fcw[2 * FF2 + hu + e];
                    wu0[e] = fcw[FFH + hu + e]; wu1[e] = fcw[FF2 + FFH + hu + e]; wu2[e] = fcw[2 * FF2 + FFH + hu + e]; g1[e] = 0.f; g2[e] = 0.f; u1[e] = 0.f; u2[e] = 0.f; }
                const size_t l0 = (size_t)run * 16; const bool bstart = ((roff + l0) % TSEQ) == 0;
                if (!bstart) { unpack8(*(const u32x4*)(Hh + (l0 - 2) * FF2 + cg_), g2); unpack8(*(const u32x4*)(Hh + (l0 - 1) * FF2 + cg_), g1);
                               unpack8(*(const u32x4*)(Hh + (l0 - 2) * FF2 + cu_), u2); unpack8(*(const u32x4*)(Hh + (l0 - 1) * FF2 + cu_), u1); }
#pragma unroll
                for (int hb = 0; hb < 2; ++hb) {
                    u32x4 rg[8], ru[8];
                    const bf16* ph = Hh + (l0 + hb * 8) * FF2 + cg_; bf16* pa = ACT + (l0 + hb * 8) * FFH + hu; asm volatile("" : "+v"(ph), "+v"(pa));
#pragma unroll
                    for (int i = 0; i < 8; ++i) { rg[i] = *(const u32x4*)(ph + i * FF2); ru[i] = *(const u32x4*)(ph + i * FF2 + 128); }
#pragma unroll
                    for (int i = 0; i < 8; ++i) { float g0[8], u0[8], o[8];
                        unpack8(rg[i], g0); unpack8(ru[i], u0);
#pragma unroll
                        for (int e = 0; e < 8; ++e) { const float cgv = wg0[e] * g2[e] + wg1[e] * g1[e] + wg2[e] * g0[e]; const float cuv = wu0[e] * u2[e] + wu1[e] * u1[e] + wu2[e] * u0[e];
                            o[e] = siluf_(cgv) * cuv; g2[e] = g1[e]; g1[e] = g0[e]; u2[e] = u1[e]; u1[e] = u0[e]; }
                        *(u32x4*)(pa + i * FFH) = pack8(o); }
                }
            }
        }
        GRID_BAR();
            if (PHMASK & (1u << 10)) {
        DECL_PTRS();
            int kq_ = FFH; asm volatile("" : "+s"(kq_));
        pg8::Gemm g{ACT, WDN_T, 16384, 1024, kq_}; pg8::StaticOrder S; S.init(16384, 1024, G, bx);
            EpiRes E{X2, X2, nullptr, RS3, roff};
            pg8::gemm_phase<EpiRes, pg8::StaticOrder, true, true>(lds, g, S, E);
        }
        GRID_BAR();
        }
    if (PHMASK & (1u << 11)) {
        DECL_PTRS();
        const float* fg = args.in[I_FING];
        f32x4 gv[4];
#pragma unroll
        for (int j = 0; j < 4; ++j) gv[j] = *((const f32x4*)fg + lane + 64 * j);
        for (int m = gw; m < M_TOK; m += 4 * NGW) {
            f32x4 v[4][4]; float rs[4];
#pragma unroll
            for (int q = 0; q < 4; ++q) { const int mm = m + q * NGW; rs[q] = RS3[mm];
#pragma unroll
                for (int j = 0; j < 4; ++j) v[q][j] = *((const f32x4*)(X2 + (size_t)mm * DM) + lane + 64 * j); }
#pragma unroll
            for (int q = 0; q < 4; ++q) { const int mm = m + q * NGW; const float r_ = __frsqrt_rn(rs[q] * (1.0f / DM) + 1e-6f);
#pragma unroll
                for (int j = 0; j < 4; ++j) *((f32x4*)(X2 + (size_t)mm * DM) + lane + 64 * j) = v[q][j] * r_ * gv[j]; }
        }
    }
    if (args.never) grid.sync();
}

extern "C" void kernel_launch(void* const* d_in, const int* in_sizes, int n_in, void* d_out, int out_size, void* d_ws, size_t ws_size, hipStream_t stream) {
    static int grid = 0;
    if (grid == 0) {
        if (n_in != 26 || in_sizes[0] != M_TOK * DM || out_size != M_TOK * DM || ws_size < WS_NEED) {
            fprintf(stderr, "kernel_launch: unexpected problem (n_in %d, in0 %d, out %d, ws %zu); nothing launched\n", n_in, n_in > 0 ? in_sizes[0] : -1, out_size, ws_size); grid = -1; return; }
        int dev = 0, cus = 0, per_cu = 0;
        hipGetDevice(&dev); hipDeviceGetAttribute(&cus, hipDeviceAttributeMultiprocessorCount, dev);
        hipFuncSetAttribute((const void*)hybrid_fwd, hipFuncAttributeMaxDynamicSharedMemorySize, LDS_BYTES);
        hipOccupancyMaxActiveBlocksPerMultiprocessor(&per_cu, (const void*)hybrid_fwd, NWAVES * 64, LDS_BYTES);
        (void)hipGetLastError();
        if (per_cu < 1) per_cu = 1;
        grid = cus;
        if (grid != 256) fprintf(stderr, "kernel_launch: %d CUs (expected 256)\n", grid);
    }
    if (grid < 0) return;
    hipMemsetAsync((char*)d_ws + WS_CTL, 0, CTL_ZERO_BYTES, stream);
    Args a{};
    for (int i = 0; i < 26; ++i) a.in[i] = (const float*)d_in[i];
    a.out = (float*)d_out; a.ws = (unsigned char*)d_ws; a.never = 0; a.pad = 0;
    void* kargs[] = {&a};
    hipError_t e = hipLaunchCooperativeKernel((const void*)hybrid_fwd, dim3(grid), dim3(NWAVES * 64), kargs, LDS_BYTES, stream);
    if (e != hipSuccess) fprintf(stderr, "cooperative launch failed: %s (grid %d)\n", hipGetErrorString(e), grid);
}
```

```cpp
#include <hip/hip_runtime.h>
#include <hip/hip_cooperative_groups.h>
#include <cstdio>
#include <cstdint>
namespace cg = cooperative_groups;
namespace pg8 {
#define PG8_LAS __attribute__((address_space(3)))
typedef unsigned short bf16_t;
typedef short bf16x8 __attribute__((ext_vector_type(8)));
typedef float f32x4 __attribute__((ext_vector_type(4)));
typedef unsigned u32x4 __attribute__((ext_vector_type(4)));
constexpr int BM = 256, BK = 64, HALF = 128, HTB = HALF * BK * 2  , STAGE_BYTES = 8 * HTB, NXCD = 8, WGM = 8;

__host__ __device__ __forceinline__ int lds_byte(int r, int c) { const int st = (r >> 4) * 2 + (c >> 5), rr = r & 15, cc = c & 31, ob = rr * 64 + cc * 2; return st * 1024 + (ob ^ (((ob >> 9) & 1) << 5)); }
__host__ __device__ __forceinline__ void stage_rc(int b, int& R, int& C) { const int st = b / 1024, sb = b % 1024, swz = sb ^ (((sb >> 9) & 1) << 5); R = (st >> 1) * 16 + swz / 64; C = (st & 1) * 32 + (swz % 64) / 2; }
__host__ __device__ __forceinline__ int perm32(int rho) { const int n = rho >> 4, i = rho & 15; return 8 * (i >> 2) + 4 * n + (i & 3); }

struct Unit { int pm, pn; };
struct Gemm { const bf16_t* A; const bf16_t* Bt; int M, N, K; };

struct StaticOrder {
    int nM, nN, nwg, G, c;
    __host__ __device__ void init(int M, int N, int G_, int c_) { nM = M / BM; nN = N / BM; nwg = nM * nN; G = G_; c = c_; }
    __host__ __device__ bool next(int i, Unit& u) const {
        const long L = (long)i * G + c; if (L >= nwg) return false;
        int wgid = (int)L; { const int q = nwg / NXCD, r = nwg % NXCD, xcd = wgid % NXCD, off = wgid / NXCD; wgid = (xcd < r ? xcd * (q + 1) : r * (q + 1) + (xcd - r) * q) + off; }
        const int nig = WGM * nN, gid = wgid / nig, fm = gid * WGM, gsz = (nM - fm) < WGM ? (nM - fm) : WGM;
        u.pm = fm + ((wgid % nig) % gsz); u.pn = (wgid % nig) / gsz; return true;
    }
    __device__ __forceinline__ void a_ready(const Unit&) const {}
    __device__ __forceinline__ void done(const Unit&) const {}
};

__device__ __forceinline__ unsigned cvt_pk_bf16(float lo, float hi) { unsigned r; asm volatile("v_cvt_pk_bf16_f32 %0, %1, %2" : "=v"(r) : "v"(lo), "v"(hi)); return r; }
typedef float f32x2 __attribute__((ext_vector_type(2)));
template <class Epi, class Sched, bool ALIGN_EPI = false, bool SP2 = false>
__device__ __forceinline__ void gemm_phase(PG8_LAS unsigned char* lds, const Gemm g, const Sched& S, const Epi& E) {
    int tid_l = threadIdx.x; asm volatile("" : "+v"(tid_l));
    const int tid = tid_l, wid = __builtin_amdgcn_readfirstlane(tid >> 6), lane = tid & 63, wr = wid >> 2, wc = wid & 3, fr = lane & 15, fq = lane >> 4;
    const int K = g.K, nt = K / BK;
    unsigned voffA[2], voffB[2];
#pragma unroll
    for (int i = 0; i < 2; ++i) { int R, C; stage_rc(tid * 16 + i * 8192, R, C); const int Rb = Epi::PERM ? ((R & ~31) + perm32(R & 31)) : R;
        voffA[i] = (unsigned)(R * K + C) * 2u; voffB[i] = (unsigned)(Rb * K + C) * 2u; }
    const size_t kstep = (size_t)(BK * 2);
    const size_t hstep = (size_t)HALF * K * 2;
    const size_t tstep = 2 * hstep;
    const unsigned ldsw = (unsigned)wid * 1024u;
    const int aoff = lds_byte(wr * 64 + fr, fq * 8), boff = lds_byte(wc * 32 + fr, fq * 8);
#define PG8_SA(b, h) (((b) * 2 + (h)) * HTB)
#define PG8_SB(b, h) ((4 + (b) * 2 + (h)) * HTB)
#define PG8_STAGE(bufoff, gbase, voff) do { _Pragma("unroll") for (int _i = 0; _i < 2; ++_i) \
        __builtin_amdgcn_global_load_lds((const unsigned*)((const char*)(gbase) + (voff)[_i]), (PG8_LAS unsigned*)(lds + (bufoff) + ldsw + _i * 8192), 16, 0, 0); } while (0)
#define PG8_LDA(dst, b, h) do { _Pragma("unroll") for (int m = 0; m < 4; ++m) _Pragma("unroll") for (int k = 0; k < 2; ++k) dst[m][k] = *(const PG8_LAS bf16x8*)(lds + PG8_SA(b, h) + aoff + m * 2048 + k * 1024); } while (0)
#define PG8_LDB(dst, b, h) do { _Pragma("unroll") for (int n = 0; n < 2; ++n) _Pragma("unroll") for (int k = 0; k < 2; ++k) dst[n][k] = *(const PG8_LAS bf16x8*)(lds + PG8_SB(b, h) + boff + n * 2048 + k * 1024); } while (0)
#define PG8_MMA(ai, bj, At, Bt) do { __builtin_amdgcn_s_setprio(1); _Pragma("unroll") for (int m = 0; m < 4; ++m) _Pragma("unroll") for (int n = 0; n < 2; ++n) _Pragma("unroll") for (int k = 0; k < 2; ++k) \
        acc[ai][bj][m][n] = __builtin_amdgcn_mfma_f32_16x16x32_bf16(Bt[n][k], At[m][k], acc[ai][bj][m][n], 0, 0, 0); __builtin_amdgcn_s_setprio(0); } while (0)
#define PG8_WAIT_V(n) asm volatile("s_waitcnt vmcnt(" #n ")" ::: "memory")
#define PG8_WAIT_L(n) asm volatile("s_waitcnt lgkmcnt(" #n ")" ::: "memory")
#define PG8_BAR __builtin_amdgcn_s_barrier()
#define PG8_SCHED __builtin_amdgcn_sched_barrier(0)
    Unit cur, nxt; int ui = 0;
    if (!S.next(0, cur)) return;
    f32x4 acc[2][2][4][2];
#pragma unroll
    for (int a = 0; a < 2; ++a)
#pragma unroll
        for (int b = 0; b < 2; ++b)
#pragma unroll
            for (int m = 0; m < 4; ++m)
#pragma unroll
                for (int n = 0; n < 2; ++n) acc[a][b][m][n] = (f32x4){0.f, 0.f, 0.f, 0.f};
    bf16x8 At[4][2], B0[2][2], B1[2][2];
    const char* cA = (const char*)g.A + (size_t)cur.pm * tstep; const char* cB = (const char*)g.Bt + (size_t)cur.pn * tstep;
    S.a_ready(cur);
    if constexpr (SP2) {
        PG8_STAGE(PG8_SB(0, 0), cB, voffB); PG8_STAGE(PG8_SB(0, 1), cB + hstep, voffB); PG8_STAGE(PG8_SA(0, 0), cA, voffA); PG8_STAGE(PG8_SA(0, 1), cA + hstep, voffA);
        if (wr == 1) PG8_BAR;
        PG8_WAIT_V(2); PG8_BAR;
        PG8_STAGE(PG8_SB(1, 0), cB + kstep, voffB); PG8_STAGE(PG8_SA(1, 0), cA + kstep, voffA); PG8_STAGE(PG8_SB(1, 1), cB + hstep + kstep, voffB);
        PG8_WAIT_V(6); PG8_BAR;
    } else {
        PG8_STAGE(PG8_SB(0, 0), cB, voffB); PG8_STAGE(PG8_SA(0, 0), cA, voffA); PG8_STAGE(PG8_SB(0, 1), cB + hstep, voffB); PG8_STAGE(PG8_SA(0, 1), cA + hstep, voffA);
        if (wr == 1) PG8_BAR;
        PG8_WAIT_V(4); PG8_BAR;
        PG8_STAGE(PG8_SB(1, 0), cB + kstep, voffB); PG8_STAGE(PG8_SA(1, 0), cA + kstep, voffA); PG8_STAGE(PG8_SB(1, 1), cB + hstep + kstep, voffB);
        PG8_WAIT_V(6); PG8_BAR;
    }
    for (;;) {
        const bool has_next = S.next(ui + 1, nxt);
        const char* nA = has_next ? (const char*)g.A + (size_t)nxt.pm * tstep : cA; const char* nB = has_next ? (const char*)g.Bt + (size_t)nxt.pn * tstep : cB;
        for (int t = 0; t < nt; t += 2) {
            const bool last = (t == nt - 2);
            const char* a1 = cA + (size_t)(t + 1) * kstep;
            const char* a2 = last ? nA : cA + (size_t)(t + 2) * kstep; const char* b2 = last ? nB : cB + (size_t)(t + 2) * kstep;
            const char* a3 = a2 + kstep; const char* b3 = b2 + kstep;
            if (last && has_next) S.a_ready(nxt);
            if constexpr (SP2) {
            PG8_LDB(B0, 0, 0); PG8_LDB(B1, 0, 1); PG8_SCHED; PG8_LDA(At, 0, 0); PG8_STAGE(PG8_SA(1, 1), a1 + hstep, voffA);
            PG8_WAIT_V(8); PG8_WAIT_L(0); PG8_BAR; PG8_MMA(0, 0, At, B0); PG8_MMA(0, 1, At, B1); PG8_BAR; PG8_SCHED;
            PG8_LDA(At, 0, 1); PG8_STAGE(PG8_SB(0, 0), b2, voffB); PG8_STAGE(PG8_SB(0, 1), b2 + hstep, voffB); PG8_STAGE(PG8_SA(0, 0), a2, voffA);
            PG8_WAIT_V(8); PG8_WAIT_L(0); PG8_BAR; PG8_MMA(1, 0, At, B0); PG8_MMA(1, 1, At, B1); PG8_BAR; PG8_SCHED;
            PG8_LDB(B0, 1, 0); PG8_LDB(B1, 1, 1); PG8_SCHED; PG8_LDA(At, 1, 0); PG8_STAGE(PG8_SA(0, 1), a2 + hstep, voffA);
            PG8_WAIT_V(8); PG8_WAIT_L(0); PG8_BAR; PG8_MMA(0, 0, At, B0); PG8_MMA(0, 1, At, B1); PG8_BAR; PG8_SCHED;
            PG8_LDA(At, 1, 1); PG8_STAGE(PG8_SB(1, 0), b3, voffB); PG8_STAGE(PG8_SB(1, 1), b3 + hstep, voffB); PG8_STAGE(PG8_SA(1, 0), a3, voffA);
            PG8_WAIT_V(8); PG8_WAIT_L(0); PG8_BAR; PG8_MMA(1, 0, At, B0); PG8_MMA(1, 1, At, B1); PG8_BAR; PG8_SCHED;
            } else {
            PG8_LDB(B0, 0, 0); PG8_SCHED; PG8_LDA(At, 0, 0); PG8_STAGE(PG8_SA(1, 1), a1 + hstep, voffA);
            PG8_WAIT_L(8); PG8_BAR; PG8_WAIT_L(0); PG8_MMA(0, 0, At, B0); PG8_BAR; PG8_SCHED;
            PG8_LDB(B1, 0, 1); PG8_STAGE(PG8_SB(0, 0), b2, voffB);
            PG8_BAR; PG8_WAIT_L(0); PG8_MMA(0, 1, At, B1); PG8_BAR;
            PG8_LDA(At, 0, 1); PG8_STAGE(PG8_SA(0, 0), a2, voffA);
            PG8_BAR; PG8_WAIT_L(0); PG8_MMA(1, 0, At, B0); PG8_BAR; PG8_SCHED;
            PG8_STAGE(PG8_SB(0, 1), b2 + hstep, voffB);
            PG8_WAIT_V(6); PG8_BAR; PG8_MMA(1, 1, At, B1); PG8_BAR;
            PG8_LDB(B0, 1, 0); PG8_SCHED; PG8_LDA(At, 1, 0); PG8_STAGE(PG8_SA(0, 1), a2 + hstep, voffA);
            PG8_WAIT_L(8); PG8_BAR; PG8_WAIT_L(0); PG8_MMA(0, 0, At, B0); PG8_BAR; PG8_SCHED;
            PG8_LDB(B1, 1, 1); PG8_STAGE(PG8_SB(1, 0), b3, voffB);
            PG8_BAR; PG8_WAIT_L(0); PG8_MMA(0, 1, At, B1); PG8_BAR;
            PG8_LDA(At, 1, 1); PG8_STAGE(PG8_SA(1, 0), a3, voffA);
            PG8_BAR; PG8_WAIT_L(0); PG8_MMA(1, 0, At, B0); PG8_BAR; PG8_SCHED;
            PG8_STAGE(PG8_SB(1, 1), b3 + hstep, voffB);
            PG8_WAIT_V(6); PG8_BAR; PG8_MMA(1, 1, At, B1); PG8_BAR;
            }
        }
        if constexpr (ALIGN_EPI) { if (wr == 0) PG8_BAR; }
        if constexpr (!Epi::AFTER_DRAIN) { E(acc, cur, wr, wc, fr, fq); S.done(cur); }
        if (!has_next) break;
#pragma unroll
        for (int a = 0; a < 2; ++a)
#pragma unroll
            for (int b = 0; b < 2; ++b)
#pragma unroll
                for (int m = 0; m < 4; ++m)
#pragma unroll
                    for (int n = 0; n < 2; ++n) acc[a][b][m][n] = (f32x4){0.f, 0.f, 0.f, 0.f};
        cur = nxt; cA = nA; cB = nB; ++ui;
        if constexpr (ALIGN_EPI) { if (wr == 1) PG8_BAR; }
    }
    PG8_WAIT_V(0);
    if constexpr (!ALIGN_EPI) { if (wr == 0) PG8_BAR; }
    PG8_BAR;
    if constexpr (Epi::AFTER_DRAIN) { E.fused(acc, cur, wr, wc, fr, fq, lds, wid, lane); S.done(cur); }
#undef PG8_SA
#undef PG8_SB
#undef PG8_STAGE
#undef PG8_LDA
#undef PG8_LDB
#undef PG8_MMA
#undef PG8_WAIT_V
#undef PG8_WAIT_L
#undef PG8_BAR
#undef PG8_SCHED
}
}

#define LAS __attribute__((address_space(3)))
typedef unsigned short bf16;
typedef unsigned u32x4 __attribute__((ext_vector_type(4)));
typedef unsigned u32x2 __attribute__((ext_vector_type(2)));
typedef float f32x4 __attribute__((ext_vector_type(4)));
typedef float f32x2 __attribute__((ext_vector_type(2)));

constexpr int NWAVES = 8;
constexpr int M_TOK = 32768, TSEQ = 4096, DM = 1024;
constexpr int NP1 = 5888;
constexpr int FFH = 2816, FF2 = 5632;
constexpr size_t MiB = 1u << 20;
constexpr size_t WS_CTL = 0, CTL_ZERO_BYTES = 1 * MiB;
constexpr size_t CTL_RS2 = 256 * 1024, CTL_RS3 = 384 * 1024;
constexpr size_t WS_WIN = 1 * MiB, WS_WPROJ = 13 * MiB, WS_WOUT = 15 * MiB, WS_WLORA = 17 * MiB;
constexpr size_t WS_PG = 18 * MiB, WS_PZ = 146 * MiB, WS_PQ = 178 * MiB, WS_XN = 274 * MiB;
constexpr size_t WS_GV = 338 * MiB, WS_R = 370 * MiB, WS_K = 402 * MiB, WS_V = 434 * MiB, WS_KK = 466 * MiB;
constexpr size_t WS_ALPHA = 498 * MiB, WS_BETA = 499 * MiB;
constexpr size_t WS_BP = 178 * MiB, WS_G = 210 * MiB, WS_WUP = 242 * MiB, WS_WDN = 253 * MiB;
constexpr size_t WS_GQ = 274 * MiB, WS_GK = 306 * MiB;
constexpr size_t WS_YAB = 274 * MiB, WS_MIX = 370 * MiB, WS_X2B = 434 * MiB;
constexpr size_t WS_H = 18 * MiB, WS_ACT = 274 * MiB;
constexpr size_t WS_NEED = 512 * MiB;
constexpr size_t DO_PR = 0, DO_ALORA = 112 * MiB, DO_DEC = 0, DO_Y = 64 * MiB, DO_O = 96 * MiB;

constexpr int LDS_BYTES = 147456;
#ifndef PHMASK
#define PHMASK 0xFFFFu
#endif
#ifndef DUPMASK
#define DUPMASK 0x0u
#endif

__device__ __forceinline__ float bf_lo(unsigned u) { return __uint_as_float(u << 16); }
__device__ __forceinline__ float bf_hi(unsigned u) { return __uint_as_float(u & 0xffff0000u); }
__device__ __forceinline__ unsigned pk2(float lo, float hi) { return pg8::cvt_pk_bf16(lo, hi); }
__device__ __forceinline__ void unpack8(const u32x4 u, float (&f)[8]) {
    f[0] = bf_lo(u.x); f[1] = bf_hi(u.x); f[2] = bf_lo(u.y); f[3] = bf_hi(u.y); f[4] = bf_lo(u.z); f[5] = bf_hi(u.z); f[6] = bf_lo(u.w); f[7] = bf_hi(u.w);
}
__device__ __forceinline__ u32x4 pack8(const float (&f)[8]) { u32x4 o; o.x = pk2(f[0], f[1]); o.y = pk2(f[2], f[3]); o.z = pk2(f[4], f[5]); o.w = pk2(f[6], f[7]); return o; }
__device__ __forceinline__ float sigmoidf_(float x) { return __builtin_amdgcn_rcpf(1.0f + __expf(-x)); }
__device__ __forceinline__ float siluf_(float x) { return x * sigmoidf_(x); }
#define LDS_WAIT() asm volatile("s_waitcnt lgkmcnt(0)" ::: "memory")
#define WG_BAR() do { asm volatile("s_waitcnt lgkmcnt(0)" ::: "memory"); __builtin_amdgcn_s_barrier(); asm volatile("" ::: "memory"); } while (0)

__device__ __forceinline__ float fma_(float a, float b, float c) { float d; asm("v_fma_f32 %0, %1, %2, %3" : "=v"(d) : "v"(a), "v"(b), "v"(c)); return d; }
__device__ __forceinline__ float mul_(float a, float b) { float d; asm("v_mul_f32 %0, %1, %2" : "=v"(d) : "v"(a), "v"(b)); return d; }
__device__ __forceinline__ float add_(float a, float b) { float d; asm("v_add_f32 %0, %1, %2" : "=v"(d) : "v"(a), "v"(b)); return d; }
#define LO2(v) __builtin_shufflevector((v), (v), 0, 1)
#define HI2(v) __builtin_shufflevector((v), (v), 2, 3)
__device__ __forceinline__ f32x2 pfma(f32x2 a, f32x2 b, f32x2 c) { return __builtin_elementwise_fma(a, b, c); }
__device__ __forceinline__ f32x2 bc2(float x) { return (f32x2){x, x}; }
template <int CTRL> __device__ __forceinline__ float dppf(float x) {
    return __int_as_float(__builtin_amdgcn_update_dpp(0, __float_as_int(x), CTRL, 0xF, 0xF, true));
}
__device__ __forceinline__ float red16(float x) { x += dppf<0xB1>(x); x += dppf<0x4E>(x); x += dppf<0x141>(x); x += dppf<0x140>(x); return x; }
__device__ __forceinline__ float red8(float x) { x += dppf<0xB1>(x); x += dppf<0x4E>(x); x += dppf<0x141>(x); return x; }
__device__ __forceinline__ float wave_sum(float v) {
#pragma unroll
    for (int o = 1; o < 64; o <<= 1) v += __shfl_xor(v, o);
    return v;
}

#define GAS __attribute__((address_space(1)))
#define XB_TMO      128
#define XB_XCNT(j)  (256  + 64 * (j))
#define XB_XSUB(j)  (1280 + 64 * (j))
#define XB_XGEN(j)  (2304 + 64 * (j))
#define XB_TOP      3328
#define XB_TOPGEN   3392
#define XCD_BAR_WORDS 3456
#define XB_SPIN_CAP (1u << 18)

__device__ __forceinline__ unsigned xb_ld(unsigned* p)              { return __hip_atomic_load(p, __ATOMIC_RELAXED, __HIP_MEMORY_SCOPE_AGENT); }
__device__ __forceinline__ unsigned xb_add(unsigned* p, unsigned v) { return __hip_atomic_fetch_add(p, v, __ATOMIC_RELAXED, __HIP_MEMORY_SCOPE_AGENT); }
__device__ __forceinline__ unsigned xb_xcc_id() { return (unsigned)__builtin_amdgcn_s_getreg((3 << 11) | 20) & 0xFu; }
#define XB_SPIN(cond, bar) do { unsigned _sp = 0; while (cond) { __builtin_amdgcn_s_sleep(1); \
    if ((++_sp & 255u) == 0u) { if (xb_ld(&(bar)[XB_TMO])) break; if (_sp > XB_SPIN_CAP) { atomicAdd(&(bar)[XB_TMO], 1u); break; } } } } while (0)

struct XcdBarrier {
    unsigned* bar; unsigned x;
    volatile LAS unsigned* st;
};

__device__ __forceinline__ XcdBarrier xcd_barrier_post(unsigned* bar, volatile LAS unsigned* st) {
    XcdBarrier b; b.bar = bar; b.x = xb_xcc_id(); b.st = st;
    if (threadIdx.x == 0) (void)xb_add(&bar[XB_XCNT(b.x)], 1u);
    return b;
}
__device__ __forceinline__ void xcd_barrier_complete(unsigned* bar, unsigned x, unsigned& nloc, unsigned& nx) {
    const unsigned G = gridDim.x * gridDim.y * gridDim.z;
    unsigned sum, cnt, mine, sp = 0u;
    for (;;) {
        sum = 0u; cnt = 0u; mine = 0u;
#pragma unroll
        for (unsigned j = 0; j < 16; ++j) { const unsigned c = xb_ld(&bar[XB_XCNT(j)]); sum += c; cnt += (c > 0u) ? 1u : 0u; mine = (j == x) ? c : mine; }
        if (sum == G) break;
        __builtin_amdgcn_s_sleep(1);
        if ((++sp & 255u) == 0u) { if (xb_ld(&bar[XB_TMO])) break; if (sp > XB_SPIN_CAP) { atomicAdd(&bar[XB_TMO], 1u); break; } }
    }
    nloc = mine > 0u ? mine : 1u; nx = cnt > 0u ? cnt : 1u;
}

__device__ __forceinline__ void xcd_barrier(const XcdBarrier& b) {
    asm volatile("s_waitcnt vmcnt(0)" ::: "memory");
    __syncthreads();
    if (threadIdx.x == 0) {
        unsigned* bar = b.bar;
        __builtin_amdgcn_s_waitcnt(0);
        unsigned nloc = b.st[0], nx = b.st[1];
        const unsigned old = xb_add(&bar[XB_XSUB(b.x)], 1u);
        const unsigned gen = old / nloc;
        if (old + 1u == (gen + 1u) * nloc) {
            __builtin_amdgcn_fence(__ATOMIC_RELEASE, "agent");
            asm volatile("s_waitcnt vmcnt(0)" ::: "memory");
            const unsigned og = xb_add(&bar[XB_TOP], 1u);
            const unsigned tg = og / nx;
            if (og + 1u == (tg + 1u) * nx) xb_add(&bar[XB_TOPGEN], 1u);
            else XB_SPIN(xb_ld(&bar[XB_TOPGEN]) == tg, bar);
            __builtin_amdgcn_fence(__ATOMIC_ACQUIRE, "agent");
            xb_add(&bar[XB_XGEN(b.x)], 1u);
            asm volatile("s_waitcnt vmcnt(0)" ::: "memory");
        } else {
            XB_SPIN(xb_ld(&bar[XB_XGEN(b.x)]) == gen, bar);
            __builtin_amdgcn_fence(__ATOMIC_ACQUIRE, "agent");
            asm volatile("s_waitcnt vmcnt(0)" ::: "memory");
        }
    }
    __syncthreads();
}

__device__ __forceinline__ void tr_item(const float* __restrict__ W, int ldw, int src_col, int k0, bf16* __restrict__ WT, int ldk, int dst_row,
                                        const float* __restrict__ gain, LAS float* scr, int lane) {
#pragma unroll 8
    for (int i = 0; i < 32; ++i) { const int kk = 2 * i + (lane >> 5); float g = gain ? gain[k0 + kk] : 1.0f;
        scr[kk * 33 + (lane & 31)] = W[(size_t)(k0 + kk) * ldw + src_col + (lane & 31)] * g; }
    LDS_WAIT(); asm volatile("" ::: "memory");
    const int c = lane & 7;
#pragma unroll
    for (int j = 0; j < 4; ++j) { const int n = (lane >> 3) + 8 * j; const LAS float* s = scr + (8 * c) * 33 + n;
        u32x4 o; o.x = pk2(s[0 * 33], s[1 * 33]); o.y = pk2(s[2 * 33], s[3 * 33]); o.z = pk2(s[4 * 33], s[5 * 33]); o.w = pk2(s[6 * 33], s[7 * 33]);
        *(u32x4*)(WT + (size_t)(dst_row + n) * ldk + k0 + 8 * c) = o; }
    LDS_WAIT(); asm volatile("" ::: "memory");
}

struct EpiP1 {
    static constexpr bool PERM = true, AFTER_DRAIN = false;
    bf16 *PR, *PQ, *PZ, *PG;
    __device__ __forceinline__ void operator()(const pg8::f32x4 (&acc)[2][2][4][2], const pg8::Unit& u, int wr, int wc, int fr, int fq) const {
        bf16* base; int ld, ct; const int pn = u.pn;
        if (pn < 7) { base = PR; ld = 1792; ct = pn; } else if (pn < 13) { base = PQ; ld = 1536; ct = pn - 7; } else if (pn < 15) { base = PZ; ld = 512; ct = pn - 13; } else { base = PG; ld = 2048; ct = pn - 15; }
        const int row0 = u.pm * 256 + wr * 64 + fr, col0 = ct * 256 + wc * 32 + 8 * fq;
#pragma unroll
        for (int ai = 0; ai < 2; ++ai)
#pragma unroll
            for (int m = 0; m < 4; ++m) { bf16* rowp = base + (size_t)(row0 + ai * 128 + m * 16) * ld + col0;
#pragma unroll
                for (int bj = 0; bj < 2; ++bj) { const pg8::f32x4 v0 = acc[ai][bj][m][0], v1 = acc[ai][bj][m][1];
                    u32x4 w; w.x = pk2(v0[0], v0[1]); w.y = pk2(v0[2], v0[3]); w.z = pk2(v1[0], v1[1]); w.w = pk2(v1[2], v1[3]);
                    *(u32x4*)(rowp + bj * 128) = w; } }
    }
};
struct EpiP3 {
    static constexpr bool PERM = true, AFTER_DRAIN = false;
    float* DEC; bf16* K; const bf16* KK; bf16* BP; bf16* G; const float *w0, *a0, *k_a;
    __device__ __forceinline__ void operator()(const pg8::f32x4 (&acc)[2][2][4][2], const pg8::Unit& u, int wr, int wc, int fr, int fq) const {
        const int grp = u.pn >> 1;
        const int row0 = u.pm * 256 + wr * 64 + fr, col0 = (u.pn & 1) * 256 + wc * 32 + 8 * fq;
#pragma unroll
        for (int ai = 0; ai < 2; ++ai)
#pragma unroll
            for (int m = 0; m < 4; ++m) {
#pragma unroll
                for (int bj = 0; bj < 2; ++bj) {
                    const int col = col0 + bj * 128;
                    const size_t off = (size_t)(row0 + ai * 128 + m * 16) * 512 + col;
                    const pg8::f32x4 v0 = acc[ai][bj][m][0], v1 = acc[ai][bj][m][1];
                    float v[8] = {v0[0], v0[1], v0[2], v0[3], v1[0], v1[1], v1[2], v1[3]};
                    if (grp == 0) {
                        const f32x4 pa = *(const f32x4*)(w0 + col), pb = *(const f32x4*)(w0 + col + 4);
                        const float p0[8] = {pa[0], pa[1], pa[2], pa[3], pb[0], pb[1], pb[2], pb[3]};
                        float d[8];
#pragma unroll
                        for (int e = 0; e < 8; ++e) d[e] = __expf(-0.60653065971f * sigmoidf_(p0[e] + v[e]));
                        *(f32x4*)(DEC + off) = (f32x4){d[0], d[1], d[2], d[3]}; *(f32x4*)(DEC + off + 4) = (f32x4){d[4], d[5], d[6], d[7]};
                    } else if (grp == 1) {
                        const f32x4 pa = *(const f32x4*)(a0 + col), pb = *(const f32x4*)(a0 + col + 4), pc = *(const f32x4*)(k_a + col), pd = *(const f32x4*)(k_a + col + 4);
                        const float p0[8] = {pa[0], pa[1], pa[2], pa[3], pb[0], pb[1], pb[2], pb[3]}, p1[8] = {pc[0], pc[1], pc[2], pc[3], pd[0], pd[1], pd[2], pd[3]};
                        float kr[8], kkv[8], kp[8], bp[8];
                        unpack8(*(const u32x4*)(K + off), kr); unpack8(*(const u32x4*)(KK + off), kkv);
#pragma unroll
                        for (int e = 0; e < 8; ++e) { const float a = sigmoidf_(p0[e] + v[e]); kp[e] = kr[e] * (1.0f + (a - 1.0f) * p1[e]); bp[e] = kkv[e] * a; }
                        *(u32x4*)(K + off) = pack8(kp); *(u32x4*)(BP + off) = pack8(bp);
                    } else {
                        *(u32x4*)(G + off) = pack8(v);
                    }
                    asm volatile("" ::: "memory");
                }
            }
    }
};
struct EpiP6 {
    static constexpr bool PERM = true, AFTER_DRAIN = false;
    const bf16* PG; bf16* MIX;
    __device__ __forceinline__ void operator()(const pg8::f32x4 (&acc)[2][2][4][2], const pg8::Unit& u, int wr, int wc, int fr, int fq) const {
        const int which = u.pm >= 128 ? 1 : 0, pm = u.pm - 128 * which, pn = u.pn - 4 * which;
        const int row0 = pm * 256 + wr * 64 + fr, col0 = pn * 256 + wc * 32 + 8 * fq;
#pragma unroll
        for (int ai = 0; ai < 2; ++ai)
#pragma unroll
            for (int m = 0; m < 4; ++m) { const size_t r = (size_t)(row0 + ai * 128 + m * 16);
#pragma unroll
                for (int bj = 0; bj < 2; ++bj) { const int col = col0 + bj * 128;
                    const pg8::f32x4 v0 = acc[ai][bj][m][0], v1 = acc[ai][bj][m][1];
                    float v[8] = {v0[0], v0[1], v0[2], v0[3], v1[0], v1[1], v1[2], v1[3]}, g[8];
                    unpack8(*(const u32x4*)(PG + r * 2048 + which * 1024 + col), g);
#pragma unroll
                    for (int e = 0; e < 8; ++e) v[e] *= sigmoidf_(g[e]);
                    if (which) { float pv[8]; unpack8(*(const u32x4*)(MIX + r * 1024 + col), pv);
#pragma unroll
                        for (int e = 0; e < 8; ++e) v[e] += pv[e]; }
                    *(u32x4*)(MIX + r * 1024 + col) = pack8(v); } asm volatile("" ::: "memory"); }
    }
};
struct EpiRes {
    static constexpr bool PERM = true, AFTER_DRAIN = false;
    const float* BASE; float* OUT; bf16* OUTB; float* RSACC; int row_off;
    __device__ __forceinline__ void operator()(const pg8::f32x4 (&acc)[2][2][4][2], const pg8::Unit& u, int wr, int wc, int fr, int fq) const {
        const int row0 = row_off + u.pm * 256 + wr * 64 + fr, col0 = u.pn * 256 + wc * 32 + 8 * fq;
#pragma unroll
        for (int ai = 0; ai < 2; ++ai)
#pragma unroll
            for (int m = 0; m < 4; ++m) { const size_t r = (size_t)(row0 + ai * 128 + m * 16); float ss = 0.f;
#pragma unroll
                for (int bj = 0; bj < 2; ++bj) { const size_t off = r * 1024 + col0 + bj * 128;
                    const f32x4 b0 = *(const f32x4*)(BASE + off), b1 = *(const f32x4*)(BASE + off + 4);
                    const pg8::f32x4 v0 = acc[ai][bj][m][0], v1 = acc[ai][bj][m][1];
                    float v[8] = {v0[0] + b0[0], v0[1] + b0[1], v0[2] + b0[2], v0[3] + b0[3], v1[0] + b1[0], v1[1] + b1[1], v1[2] + b1[2], v1[3] + b1[3]};
#pragma unroll
                    for (int e = 0; e < 8; ++e) ss += v[e] * v[e];
                    *(f32x4*)(OUT + off) = (f32x4){v[0], v[1], v[2], v[3]}; *(f32x4*)(OUT + off + 4) = (f32x4){v[4], v[5], v[6], v[7]};
                    if (OUTB) *(u32x4*)(OUTB + off) = pack8(v); }
                ss += __shfl_xor(ss, 16); ss += __shfl_xor(ss, 32);
                if (fq == 0) atomicAdd(RSACC + r, ss); asm volatile("" ::: "memory"); }
    }
};
struct EpiP8 {
    static constexpr bool PERM = true, AFTER_DRAIN = false;
    bf16* H; const float* RSACC; int row_off;
    __device__ __forceinline__ void operator()(const pg8::f32x4 (&acc)[2][2][4][2], const pg8::Unit& u, int wr, int wc, int fr, int fq) const {
        const int row0 = u.pm * 256 + wr * 64 + fr, col0 = u.pn * 256 + wc * 32 + 8 * fq;
#pragma unroll
        for (int ai = 0; ai < 2; ++ai)
#pragma unroll
            for (int m = 0; m < 4; ++m) { const int r = row0 + ai * 128 + m * 16; const float rs = __frsqrt_rn(RSACC[row_off + r] * (1.0f / 1024.0f) + 1e-6f);
#pragma unroll
                for (int bj = 0; bj < 2; ++bj) { const pg8::f32x4 v0 = acc[ai][bj][m][0] * rs, v1 = acc[ai][bj][m][1] * rs;
                    u32x4 w; w.x = pk2(v0[0], v0[1]); w.y = pk2(v0[2], v0[3]); w.z = pk2(v1[0], v1[1]); w.w = pk2(v1[2], v1[3]);
                    *(u32x4*)(H + (size_t)r * FF2 + col0 + bj * 128) = w; } asm volatile("" ::: "memory"); }
    }
};
struct PairOrder {
    pg8::StaticOrder base;
    __device__ void init(int G, int c) { base.init(M_TOK, 1024, G, c); }
    __device__ bool next(int i, pg8::Unit& u) const { pg8::Unit b; if (!base.next(i >> 1, b)) return false; const int w = i & 1; u.pm = b.pm + 128 * w; u.pn = b.pn + 4 * w; return true; }
    __device__ __forceinline__ void a_ready(const pg8::Unit&) const {}
    __device__ __forceinline__ void done(const pg8::Unit&) const {}
};

constexpr int TS = 16;
constexpr int RW_STEP = 336, RW_BUF = TS * RW_STEP;
constexpr int GD_STEP = 276, GD_BUF = TS * GD_STEP;
constexpr int GD_LDS_OFF = 2 * RW_BUF;

template <int MODE> __device__ __forceinline__ void rwkv_scan(LAS float* lds, const bf16* __restrict__ R, const bf16* __restrict__ Kp, const bf16* __restrict__ KK, const bf16* __restrict__ BP,
                                          const float* __restrict__ DEC, const bf16* __restrict__ V, bf16* __restrict__ Y, int tid, int lane, int wave) {
    const int xcd_ = blockIdx.x & 7, j_ = blockIdx.x >> 3;
    const int pair = xcd_ * 8 + (j_ >> 2), s = j_ & 3, b = pair >> 3, h = pair & 7;
    const size_t mrow0 = (size_t)b * TSEQ; const int colh = h * 64; const int i = tid;
    const int a_arr = i >> 7, a_step = (i & 127) >> 3, a_seg = i & 7;
    const bf16* srcA0 = (a_arr == 0 ? R : Kp) + (mrow0 + a_step) * 512 + colh + a_seg * 8;
    const bf16* srcA1 = (a_arr == 0 ? KK : BP) + (mrow0 + a_step) * 512 + colh + a_seg * 8;
    const int d_step = i >> 4, d_seg = i & 15;
    const float* srcD = DEC + (mrow0 + d_step) * 512 + colh + d_seg * 4;
    const int v_step = (i >> 1) & 15, v_seg = i & 1;
    const bf16* srcV = V + (mrow0 + v_step) * 512 + colh + 16 * s + v_seg * 8;
    const int dA0 = a_step * RW_STEP + (a_arr == 0 ? 0 : 128) + a_seg * 8;
    const int dA1 = a_step * RW_STEP + (a_arr == 0 ? 192 : 256) + a_seg * 8;
    const float sg1 = a_arr == 0 ? -1.0f : 1.0f;
    const int dD = d_step * RW_STEP + 64 + d_seg * 4, dV = v_step * RW_STEP + 320 + v_seg * 8;
    const int kq = lane & 15, rl = wave * 4 + (lane >> 4);
    f32x2 Sa = {0.f, 0.f}, Sb = {0.f, 0.f};
    u32x4 gA0, gA1, gV; f32x4 gD;
    gV = (u32x4){0u, 0u, 0u, 0u};
    constexpr size_t CH = (size_t)TS * 512;
#define RW_LOAD(c) do { gA0 = *(const u32x4*)(srcA0 + (size_t)(c) * CH); gA1 = *(const u32x4*)(srcA1 + (size_t)(c) * CH); gD = *(const f32x4*)(srcD + (size_t)(c) * CH); \
        if (i < 32) gV = *(const u32x4*)(srcV + (size_t)(c) * CH); } while (0)
#define RW_WRITE(B) do { float f[8]; unpack8(gA0, f); *(LAS f32x4*)((B) + dA0) = (f32x4){f[0], f[1], f[2], f[3]}; *(LAS f32x4*)((B) + dA0 + 4) = (f32x4){f[4], f[5], f[6], f[7]}; \
        unpack8(gA1, f); *(LAS f32x4*)((B) + dA1) = (f32x4){f[0] * sg1, f[1] * sg1, f[2] * sg1, f[3] * sg1}; *(LAS f32x4*)((B) + dA1 + 4) = (f32x4){f[4] * sg1, f[5] * sg1, f[6] * sg1, f[7] * sg1}; \
        *(LAS f32x4*)((B) + dD) = gD; \
        if (i < 32) { unpack8(gV, f); *(LAS f32x4*)((B) + dV) = (f32x4){f[0], f[1], f[2], f[3]}; *(LAS f32x4*)((B) + dV + 4) = (f32x4){f[4], f[5], f[6], f[7]}; } } while (0)
    if (!(MODE & 2)) { RW_LOAD(0); RW_WRITE(lds); } WG_BAR();
    constexpr int NCH = TSEQ / TS;
    for (int c = 0; c < NCH; ++c) {
        if (!(MODE & 2) && c + 1 < NCH) RW_LOAD(c + 1);
        const LAS float* B = lds + (c & 1) * RW_BUF;
        float ykeep = 0.f;
        struct RwOp { f32x4 r, w, k, a, b; float v; } ops[4];
#define RW_LD(j) do { const LAS float* P_ = B + (j) * RW_STEP; RwOp& d_ = ops[(j) & 3]; d_.a = *(const LAS f32x4*)(P_ + 192 + kq * 4); d_.w = *(const LAS f32x4*)(P_ + 64 + kq * 4); \
            d_.k = *(const LAS f32x4*)(P_ + 128 + kq * 4); d_.v = P_[320 + rl]; d_.b = *(const LAS f32x4*)(P_ + 256 + kq * 4); d_.r = *(const LAS f32x4*)(P_ + kq * 4); } while (0)
        if (!(MODE & 1)) {
        RW_LD(0); RW_LD(1);
#pragma unroll
        for (int st = 0; st < TS; ++st) {
            if (st + 2 < TS) RW_LD(st + 2);
            const RwOp& o_ = ops[st & 3];
            f32x2 p = Sa * LO2(o_.a); p = pfma(Sb, HI2(o_.a), p);
            float sa = p[0] + p[1];
            float yy = 0.f;
            if (st > 0) { const RwOp& pr_ = ops[(st - 1) & 3]; f32x2 y2 = Sa * LO2(pr_.r); y2 = pfma(Sb, HI2(pr_.r), y2); yy = y2[0] + y2[1]; }
            const f32x2 vv2 = bc2(o_.v);
            const f32x2 ta = pfma(Sa, LO2(o_.w), vv2 * LO2(o_.k)), tb = pfma(Sb, HI2(o_.w), vv2 * HI2(o_.k));
            sa = red16(sa);
            if (st > 0) { yy = red16(yy); ykeep = (kq == st - 1) ? yy : ykeep; }
            const f32x2 sa2 = bc2(sa);
            Sa = pfma(sa2, LO2(o_.b), ta); Sb = pfma(sa2, HI2(o_.b), tb);
            __builtin_amdgcn_sched_barrier(0);
        }
        { const RwOp& pr_ = ops[(TS - 1) & 3]; f32x2 y2 = Sa * LO2(pr_.r); y2 = pfma(Sb, HI2(pr_.r), y2);
          const float y = red16(y2[0] + y2[1]); ykeep = (kq == TS - 1) ? y : ykeep; }
        }
#undef RW_LD
        { const unsigned short yb = (unsigned short)(pk2(ykeep, 0.f) & 0xffffu); Y[(mrow0 + (size_t)c * TS + kq) * 512 + colh + 16 * s + rl] = yb; }
        if (!(MODE & 2) && c + 1 < NCH) { LAS float* Bn = lds + ((c + 1) & 1) * RW_BUF; RW_WRITE(Bn); }
        WG_BAR();
    }
#undef RW_LOAD
#undef RW_WRITE
}

template <int MODE> __device__ __forceinline__ void gdn_scan(LAS float* lds, const bf16* __restrict__ GQ, const bf16* __restrict__ GK, const bf16* __restrict__ GV,
                                         const float* __restrict__ ALPHA, const float* __restrict__ BETA, bf16* __restrict__ O, int tid, int lane, int wave) {
    const int xcd_ = blockIdx.x & 7, j_ = blockIdx.x >> 3;
    const int pair = xcd_ * 4 + (j_ >> 3), s = j_ & 7, b = pair >> 2, h = pair & 3;
    const size_t mrow0 = (size_t)b * TSEQ; const int colh = h * 128; const int i = tid - 256;
    const int q_step = i >> 4, q_seg = i & 15;
    const bf16* srcQ = GQ + (mrow0 + q_step) * 512 + colh + q_seg * 8;
    const bf16* srcK = GK + (mrow0 + q_step) * 512 + colh + q_seg * 8;
    const int v_step = (i >> 1) & 15, v_seg = i & 1;
    const bf16* srcV = GV + (mrow0 + v_step) * 512 + colh + 16 * s + v_seg * 8;
    const float* srcBv = BETA + (mrow0 + v_step) * 4 + h;
    const int s_step = i & 15;
    const float* srcAl = ALPHA + (mrow0 + s_step) * 4 + h; const float* srcBe = BETA + (mrow0 + s_step) * 4 + h;
    const int dQ = q_step * GD_STEP + q_seg * 8, dK = dQ + 128, dV = v_step * GD_STEP + 256 + v_seg * 8, dS = s_step * GD_STEP + 272;
    const int kq = lane & 15, rl = (wave - 4) * 4 + (lane >> 4);
    f32x2 S2[4];
#pragma unroll
    for (int e = 0; e < 4; ++e) S2[e] = (f32x2){0.f, 0.f};
    u32x4 gQ, gK, gV; float gBv = 0.f, gAl = 0.f, gBe = 0.f;
    gV = (u32x4){0u, 0u, 0u, 0u};
    constexpr size_t CH = (size_t)TS * 512; constexpr size_t CH4 = (size_t)TS * 4;
#define GD_LOAD(c) do { gQ = *(const u32x4*)(srcQ + (size_t)(c) * CH); gK = *(const u32x4*)(srcK + (size_t)(c) * CH); \
        if (i < 32) { gV = *(const u32x4*)(srcV + (size_t)(c) * CH); gBv = srcBv[(size_t)(c) * CH4]; } \
        else if (i < 48) { gAl = srcAl[(size_t)(c) * CH4]; gBe = srcBe[(size_t)(c) * CH4]; } } while (0)
#define GD_WRITE(B) do { float f[8]; unpack8(gQ, f); *(LAS f32x4*)((B) + dQ) = (f32x4){f[0], f[1], f[2], f[3]}; *(LAS f32x4*)((B) + dQ + 4) = (f32x4){f[4], f[5], f[6], f[7]}; \
        unpack8(gK, f); *(LAS f32x4*)((B) + dK) = (f32x4){f[0], f[1], f[2], f[3]}; *(LAS f32x4*)((B) + dK + 4) = (f32x4){f[4], f[5], f[6], f[7]}; \
        if (i < 32) { unpack8(gV, f); *(LAS f32x4*)((B) + dV) = (f32x4){f[0] * gBv, f[1] * gBv, f[2] * gBv, f[3] * gBv}; *(LAS f32x4*)((B) + dV + 4) = (f32x4){f[4] * gBv, f[5] * gBv, f[6] * gBv, f[7] * gBv}; } \
        else if (i < 48) { *(LAS f32x2*)((B) + dS) = (f32x2){gAl * gBe, gAl}; } } while (0)
    LAS float* base = lds + GD_LDS_OFF;
    if (!(MODE & 2)) { GD_LOAD(0); GD_WRITE(base); } WG_BAR();
    constexpr int NCH = TSEQ / TS;
    for (int c = 0; c < NCH; ++c) {
        if (!(MODE & 2) && c + 1 < NCH) GD_LOAD(c + 1);
        const LAS float* B = base + (c & 1) * GD_BUF;
        float okeep = 0.f;
        struct GdOp { f32x4 q0, q1, k0, k1; float bv; f32x2 sc; } ops[4];
#define GD_LD(j) do { const LAS float* P_ = B + (j) * GD_STEP; GdOp& d_ = ops[(j) & 3]; d_.k0 = *(const LAS f32x4*)(P_ + 128 + kq * 4); d_.k1 = *(const LAS f32x4*)(P_ + 192 + kq * 4); \
            d_.sc = *(const LAS f32x2*)(P_ + 272); d_.bv = P_[256 + rl]; d_.q0 = *(const LAS f32x4*)(P_ + kq * 4); d_.q1 = *(const LAS f32x4*)(P_ + 64 + kq * 4); } while (0)
        if (!(MODE & 1)) {
        GD_LD(0); GD_LD(1);
#pragma unroll
        for (int st = 0; st < TS; ++st) {
            if (st + 2 < TS) GD_LD(st + 2);
            const GdOp& o_ = ops[st & 3];
            f32x2 p = S2[0] * LO2(o_.k0); p = pfma(S2[1], HI2(o_.k0), p); p = pfma(S2[2], LO2(o_.k1), p); p = pfma(S2[3], HI2(o_.k1), p);
            float sa = p[0] + p[1];
            float oo = 0.f;
            if (st > 0) { const GdOp& pr_ = ops[(st - 1) & 3]; f32x2 q2 = S2[0] * LO2(pr_.q0); q2 = pfma(S2[1], HI2(pr_.q0), q2); q2 = pfma(S2[2], LO2(pr_.q1), q2); q2 = pfma(S2[3], HI2(pr_.q1), q2); oo = q2[0] + q2[1]; }
            const f32x2 al2 = bc2(o_.sc[1]);
            const f32x2 T0 = S2[0] * al2, T1 = S2[1] * al2, T2 = S2[2] * al2, T3 = S2[3] * al2;
            sa = red16(sa);
            if (st > 0) { oo = red16(oo); okeep = (kq == st - 1) ? oo : okeep; }
            const f32x2 cc2 = bc2(__builtin_fmaf(-o_.sc[0], sa, o_.bv));
            S2[0] = pfma(cc2, LO2(o_.k0), T0); S2[1] = pfma(cc2, HI2(o_.k0), T1); S2[2] = pfma(cc2, LO2(o_.k1), T2); S2[3] = pfma(cc2, HI2(o_.k1), T3);
            __builtin_amdgcn_sched_barrier(0);
        }
        { const GdOp& pr_ = ops[(TS - 1) & 3]; f32x2 q2 = S2[0] * LO2(pr_.q0); q2 = pfma(S2[1], HI2(pr_.q0), q2); q2 = pfma(S2[2], LO2(pr_.q1), q2); q2 = pfma(S2[3], HI2(pr_.q1), q2);
          const float o = red16(q2[0] + q2[1]); okeep = (kq == TS - 1) ? o : okeep; }
        }
#undef GD_LD
        { const unsigned short ob = (unsigned short)(pk2(okeep, 0.f) & 0xffffu); O[(mrow0 + (size_t)c * TS + kq) * 512 + colh + 16 * s + rl] = ob; }
        if (!(MODE & 2) && c + 1 < NCH) { LAS float* Bn = base + ((c + 1) & 1) * GD_BUF; GD_WRITE(Bn); }
        WG_BAR();
    }
#undef GD_LOAD
#undef GD_WRITE
}

struct Args { const float* in[26]; float* out; unsigned char* ws; int never; int pad; };
enum { I_X = 0, I_N1G, I_WIN, I_MU, I_W0, I_W2, I_A0, I_A2, I_G2, I_KK, I_KA, I_RK, I_LNW, I_LNB, I_RPROJ, I_GCONV, I_ALOG, I_DTB, I_GNW, I_GPROJ, I_WOUT, I_N2G, I_FUP, I_FCONV, I_FDN, I_FING };

__global__ void __launch_bounds__(NWAVES * 64, 2) hybrid_fwd(Args args) {
    extern __shared__ __attribute__((aligned(16))) unsigned char lds_raw[];
    cg::grid_group grid = cg::this_grid();
    LAS unsigned char* lds = (LAS unsigned char*)lds_raw;
    const int tid_top = threadIdx.x;
    const int G = gridDim.x, bx = blockIdx.x;
    const int NGW = G * NWAVES;
    unsigned char* ws_top = args.ws; unsigned char* dob_top = (unsigned char*)args.out;
#define DECL_PTRS() \
    int tid = tid_top; asm volatile("" : "+v"(tid)); const int lane = tid & 63, wave = __builtin_amdgcn_readfirstlane(tid >> 6), gw = bx * NWAVES + wave; (void)lane; (void)gw; \
    GAS unsigned char* wsg = (GAS unsigned char*)ws_top; GAS unsigned char* dobg = (GAS unsigned char*)dob_top; asm volatile("" : "+s"(wsg), "+s"(dobg)); \
    unsigned char* ws = (unsigned char*)wsg; unsigned char* dob = (unsigned char*)dobg; \
    const float* x = args.in[I_X]; \
    bf16* WIN_T = (bf16*)(ws + WS_WIN); bf16* WPROJ_T = (bf16*)(ws + WS_WPROJ); bf16* WOUT_T = (bf16*)(ws + WS_WOUT); bf16* WLORA_T = (bf16*)(ws + WS_WLORA); \
    bf16* WUP_T = (bf16*)(ws + WS_WUP); bf16* WDN_T = (bf16*)(ws + WS_WDN); \
    bf16* XN = (bf16*)(ws + WS_XN); bf16* PR = (bf16*)(dob + DO_PR); bf16* PQ = (bf16*)(ws + WS_PQ); bf16* PZ = (bf16*)(ws + WS_PZ); bf16* PG = (bf16*)(ws + WS_PG); \
    bf16* Rb = (bf16*)(ws + WS_R); bf16* Kb = (bf16*)(ws + WS_K); bf16* Vb = (bf16*)(ws + WS_V); bf16* KKb = (bf16*)(ws + WS_KK); bf16* ALORA = (bf16*)(dob + DO_ALORA); \
    bf16* GQ = (bf16*)(ws + WS_GQ); bf16* GK = (bf16*)(ws + WS_GK); bf16* GV = (bf16*)(ws + WS_GV); \
    float* ALPHA = (float*)(ws + WS_ALPHA); float* BETA = (float*)(ws + WS_BETA); \
    float* DEC = (float*)(dob + DO_DEC); bf16* BPb = (bf16*)(ws + WS_BP); bf16* Gb = (bf16*)(ws + WS_G); \
    bf16* Yb = (bf16*)(dob + DO_Y); bf16* Ob = (bf16*)(dob + DO_O); \
    bf16* YAB = (bf16*)(ws + WS_YAB); bf16* MIX = (bf16*)(ws + WS_MIX); bf16* X2B = (bf16*)(ws + WS_X2B); \
    bf16* Hh = (bf16*)(ws + WS_H); bf16* ACT = (bf16*)(ws + WS_ACT); \
    float* RS2 = (float*)(ws + CTL_RS2); float* RS3 = (float*)(ws + CTL_RS3); \
    float* X2 = (float*)dob;
    if (tid_top < 64) ((LAS unsigned*)(lds + 131072))[tid_top] = 0u;
    __syncthreads();
    XcdBarrier bar = xcd_barrier_post((unsigned*)(ws_top + 16384), (volatile LAS unsigned*)(lds + 131072 + 64));
    if (tid_top == 0) { unsigned nloc, nx; xcd_barrier_complete(bar.bar, bar.x, nloc, nx); bar.st[0] = nloc; bar.st[1] = nx; }
    __syncthreads();
#ifdef USE_CG
#define GRID_BAR() do { __syncthreads(); grid.sync(); } while (0)
#else
#define GRID_BAR() xcd_barrier(bar)
#endif

    _Pragma("unroll 1") for (int rep_ = 0; rep_ < 1 + (int)((DUPMASK >> 0) & 1u); ++rep_) {
    if (PHMASK & (1u << 0)) {
        DECL_PTRS();
        LAS float* scr = (LAS float*)(lds + wave * 8448);
        LAS float* WAB = (LAS float*)(lds + 73728);
        const float* w_in = args.in[I_WIN]; const float* g1 = args.in[I_N1G];
        for (int e = tid; e < 8192; e += 512) { const int k = e >> 3, j = e & 7; WAB[e] = g1[k] * w_in[(size_t)k * 5896 + 3840 + j]; }
        constexpr int IT_A = 16 * 120, IT_B = 16 * 64, IT_P = 8 * 32, IT_O = 16 * 32, NIT = IT_A + IT_B + 2 * IT_P + IT_O;
        for (int it = gw; it < NIT; it += NGW) {
            int r = it;
            if (r < IT_A) { const int kb = r / 120, nb = r % 120; tr_item(w_in, 5896, 32 * nb, 64 * kb, WIN_T, 1024, 32 * nb, g1, scr, lane); continue; } r -= IT_A;
            if (r < IT_B) { const int kb = r / 64, nb = r % 64; tr_item(w_in, 5896, 3848 + 32 * nb, 64 * kb, WIN_T, 1024, 3840 + 32 * nb, g1, scr, lane); continue; } r -= IT_B;
            if (r < IT_P) { const int kb = r / 32, nb = r % 32; tr_item(args.in[I_RPROJ], 1024, 32 * nb, 64 * kb, WPROJ_T, 512, 32 * nb, nullptr, scr, lane); continue; } r -= IT_P;
            if (r < IT_P) { const int kb = r / 32, nb = r % 32; tr_item(args.in[I_GPROJ], 1024, 32 * nb, 64 * kb, WPROJ_T, 512, 1024 + 32 * nb, nullptr, scr, lane); continue; } r -= IT_P;
            { const int kb = r / 32, nb = r % 32; tr_item(args.in[I_WOUT], 1024, 32 * nb, 64 * kb, WOUT_T, 1024, 32 * nb, nullptr, scr, lane); }
        }
        for (int e = bx * 512 + tid; e < 1536 * 256; e += G * 512) {
            const int n = e >> 8, k = e & 255, grp = n >> 9, c = n & 511; float v = 0.f;
            if (grp == 0 && k < 64) v = args.in[I_W2][k * 512 + c];
            else if (grp == 1 && k >= 64 && k < 128) v = args.in[I_A2][(k - 64) * 512 + c];
            else if (grp == 2 && k >= 128) v = args.in[I_G2][(k - 128) * 512 + c];
            WLORA_T[e] = (bf16)(pk2(v, 0.f) & 0xffffu);
        }
        __syncthreads();
        const float* a_log = args.in[I_ALOG]; const float* dtb = args.in[I_DTB];
        for (int m = gw; m < M_TOK; m += NGW) {
            const f32x4* xr = (const f32x4*)(x + (size_t)m * DM) + lane;
            f32x4 v[4]; float ss = 0.f;
#pragma unroll
            for (int j = 0; j < 4; ++j) { v[j] = xr[64 * j]; ss += (v[j][0] * v[j][0] + v[j][1] * v[j][1]) + (v[j][2] * v[j][2] + v[j][3] * v[j][3]); }
            const float rs = __frsqrt_rn(wave_sum(ss) * (1.0f / DM) + 1e-6f);
            float ab[8];
#pragma unroll
            for (int q = 0; q < 8; ++q) ab[q] = 0.f;
            unsigned long long* o8 = (unsigned long long*)(XN + (size_t)m * DM) + lane;
#pragma unroll
            for (int j = 0; j < 4; ++j) {
#pragma unroll
                for (int e = 0; e < 4; ++e) { const int k = 4 * lane + 256 * j + e; const f32x4 wa = *(const LAS f32x4*)(WAB + k * 8), wb = *(const LAS f32x4*)(WAB + k * 8 + 4); const float xv = v[j][e];
                    ab[0] += xv * wa[0]; ab[1] += xv * wa[1]; ab[2] += xv * wa[2]; ab[3] += xv * wa[3]; ab[4] += xv * wb[0]; ab[5] += xv * wb[1]; ab[6] += xv * wb[2]; ab[7] += xv * wb[3]; }
                o8[64 * j] = (unsigned long long)pk2(v[j][0] * rs, v[j][1] * rs) | ((unsigned long long)pk2(v[j][2] * rs, v[j][3] * rs) << 32);
            }
#pragma unroll
            for (int q = 0; q < 8; ++q) ab[q] = wave_sum(ab[q]) * rs;
            if (lane < 4) {
                const float araw = lane == 0 ? ab[0] : lane == 1 ? ab[1] : lane == 2 ? ab[2] : ab[3];
                const float braw = lane == 0 ? ab[4] : lane == 1 ? ab[5] : lane == 2 ? ab[6] : ab[7];
                const float z = araw + dtb[lane]; const float sp = z > 20.f ? z : log1pf(__expf(z));
                const float gg = -__expf(a_log[lane]) * sp;
                ALPHA[(size_t)m * 4 + lane] = __expf(gg); BETA[(size_t)m * 4 + lane] = sigmoidf_(braw);
            }
        }
    }
    GRID_BAR();
    }
    _Pragma("unroll 1") for (int rep_ = 0; rep_ < 1 + (int)((DUPMASK >> 1) & 1u); ++rep_) {
    if (PHMASK & (1u << 1)) {
        DECL_PTRS();
        int kq_ = DM; asm volatile("" : "+s"(kq_));
        pg8::Gemm g{XN, WIN_T, M_TOK, NP1, kq_}; pg8::StaticOrder S; S.init(M_TOK, NP1, G, bx);
        EpiP1 E{PR, PQ, PZ, PG};
        pg8::gemm_phase<EpiP1, pg8::StaticOrder, true, true>(lds, g, S, E);
    }
    GRID_BAR();
    }
    _Pragma("unroll 1") for (int rep_ = 0; rep_ < 1 + (int)((DUPMASK >> 2) & 1u); ++rep_) {
    if (PHMASK & (1u << 2)) {
        DECL_PTRS();
        const float* mu = args.in[I_MU]; const float* k_k = args.in[I_KK]; const float* cw = args.in[I_GCONV];
        constexpr int NITEM = (M_TOK / 16) * 7;
        for (int it = gw; it < NITEM; it += NGW) {
            const int part = it % 7, run = it / 7; const size_t m0 = (size_t)run * 16; const bool bstart = (m0 % TSEQ) == 0;
            if (part < 3) {
                const int c = part * 512 + 8 * lane; float mu8[8], kk8[8], prev[8];
                u32x4 raw[16];
                { const bf16* pl = PR + m0 * 1792 + c; asm volatile("" : "+v"(pl));
#pragma unroll
                for (int i = 0; i < 16; ++i) raw[i] = *(const u32x4*)(pl + i * 1792); }
#pragma unroll
                for (int e = 0; e < 8; ++e) { mu8[e] = mu[c + e]; kk8[e] = part == 1 ? k_k[8 * lane + e] : 0.f; prev[e] = 0.f; }
                if (!bstart) unpack8(*(const u32x4*)(PR + (m0 - 1) * 1792 + c), prev);
                bf16* dst = (part == 0 ? Rb : part == 1 ? Kb : Vb) + m0 * 512 + 8 * lane; bf16* dkk = KKb + m0 * 512 + 8 * lane; asm volatile("" : "+v"(dst), "+v"(dkk));
#pragma unroll
                for (int i = 0; i < 16; ++i) { float cur[8], ps[8]; unpack8(raw[i], cur);
#pragma unroll
                    for (int e = 0; e < 8; ++e) { ps[e] = cur[e] + (prev[e] - cur[e]) * mu8[e]; prev[e] = cur[e]; }
                    *(u32x4*)(dst + i * 512) = pack8(ps);
                    if (part == 1) { float kv[8], ss = 0.f;
#pragma unroll
                        for (int e = 0; e < 8; ++e) { kv[e] = ps[e] * kk8[e]; ss += kv[e] * kv[e]; }
                        ss = red8(ss); const float rn = __frsqrt_rn(ss + 1e-6f);
#pragma unroll
                        for (int e = 0; e < 8; ++e) kv[e] *= rn;
                        *(u32x4*)(dkk + i * 512) = pack8(kv); } }
            } else if (part == 3) {
                const int c = 1536 + 4 * lane; float mu4[4], prev[4] = {0.f, 0.f, 0.f, 0.f};
                u32x2 raw[16];
                { const bf16* pl = PR + m0 * 1792 + c; asm volatile("" : "+v"(pl));
#pragma unroll
                for (int i = 0; i < 16; ++i) raw[i] = *(const u32x2*)(pl + i * 1792); }
#pragma unroll
                for (int e = 0; e < 4; ++e) mu4[e] = mu[c + e];
                if (!bstart) { const u32x2 u = *(const u32x2*)(PR + (m0 - 1) * 1792 + c); prev[0] = bf_lo(u.x); prev[1] = bf_hi(u.x); prev[2] = bf_lo(u.y); prev[3] = bf_hi(u.y); }
                bf16* dal = ALORA + m0 * 256 + 4 * lane; asm volatile("" : "+v"(dal));
#pragma unroll
                for (int i = 0; i < 16; ++i) { const u32x2 u = raw[i];
                    float cur[4] = {bf_lo(u.x), bf_hi(u.x), bf_lo(u.y), bf_hi(u.y)}, o[4];
#pragma unroll
                    for (int e = 0; e < 4; ++e) { const float ps = cur[e] + (prev[e] - cur[e]) * mu4[e]; prev[e] = cur[e];
                        const float xc = fminf(fmaxf(ps, -15.f), 15.f); const float t = __expf(2.f * xc); const float th = (t - 1.f) * __builtin_amdgcn_rcpf(t + 1.f);
                        const float sg = sigmoidf_(ps);
                        o[e] = lane < 16 ? th : (lane < 32 ? ps : sg); }
                    u32x2 w; w.x = pk2(o[0], o[1]); w.y = pk2(o[2], o[3]); *(u32x2*)(dal + i * 256) = w; }
            } else {
                const int pp = part - 4, c = pp * 512 + 8 * lane; float w0[8], w1[8], w2[8], w3[8], x3[8], x2[8], x1[8];
                u32x4 raw[16];
                { const bf16* pl = PQ + m0 * 1536 + c; asm volatile("" : "+v"(pl));
#pragma unroll
                for (int i = 0; i < 16; ++i) raw[i] = *(const u32x4*)(pl + i * 1536); }
#pragma unroll
                for (int e = 0; e < 8; ++e) { w0[e] = cw[c + e]; w1[e] = cw[1536 + c + e]; w2[e] = cw[3072 + c + e]; w3[e] = cw[4608 + c + e]; x3[e] = 0.f; x2[e] = 0.f; x1[e] = 0.f; }
                if (!bstart) { unpack8(*(const u32x4*)(PQ + (m0 - 3) * 1536 + c), x3); unpack8(*(const u32x4*)(PQ + (m0 - 2) * 1536 + c), x2); unpack8(*(const u32x4*)(PQ + (m0 - 1) * 1536 + c), x1); }
                bf16* dst = (pp == 0 ? GQ : pp == 1 ? GK : GV) + m0 * 512 + 8 * lane; asm volatile("" : "+v"(dst));
#pragma unroll
                for (int i = 0; i < 16; ++i) { float x0[8], sv[8], ss = 0.f; unpack8(raw[i], x0);
#pragma unroll
                    for (int e = 0; e < 8; ++e) { const float a = w0[e] * x3[e] + w1[e] * x2[e] + w2[e] * x1[e] + w3[e] * x0[e]; sv[e] = siluf_(a); ss += sv[e] * sv[e]; x3[e] = x2[e]; x2[e] = x1[e]; x1[e] = x0[e]; }
                    if (pp < 2) { ss = red16(ss); const float rn = __frsqrt_rn(ss + 1e-6f) * (pp == 0 ? 0.08838834764831845f : 1.0f);
#pragma unroll
                        for (int e = 0; e < 8; ++e) sv[e] *= rn; }
                    *(u32x4*)(dst + i * 512) = pack8(sv); }
            }
        }
    }
    GRID_BAR();
    }
    _Pragma("unroll 1") for (int rep_ = 0; rep_ < 1 + (int)((DUPMASK >> 3) & 1u); ++rep_) {
    if (PHMASK & (1u << 3)) {
        DECL_PTRS();
        int kl = 256; asm volatile("" : "+s"(kl));
        pg8::Gemm g{ALORA, WLORA_T, M_TOK, 1536, kl}; pg8::StaticOrder S; S.init(M_TOK, 1536, G, bx);
        EpiP3 E{DEC, Kb, KKb, BPb, Gb, args.in[I_W0], args.in[I_A0], args.in[I_KA]};
        pg8::gemm_phase<EpiP3, pg8::StaticOrder, true, true>(lds, g, S, E);
    }
    GRID_BAR();
    }
    _Pragma("unroll 1") for (int rep_ = 0; rep_ < 1 + (int)((DUPMASK >> 4) & 1u); ++rep_) {
    if (PHMASK & (1u << 4)) {
        DECL_PTRS();
        if (wave < 4) rwkv_scan<0>((LAS float*)lds, Rb, Kb, KKb, BPb, DEC, Vb, Yb, tid, lane, wave);
        else gdn_scan<0>((LAS float*)lds, GQ, GK, GV, ALPHA, BETA, Ob, tid, lane, wave);
#ifdef SHADOW_A
        GRID_BAR();
        { bf16* DUMMY = (bf16*)(ws + 242 * MiB);
        if (wave < 4) rwkv_scan<SHADOW_A>((LAS float*)lds, Rb, Kb, KKb, BPb, DEC, Vb, DUMMY, tid, lane, wave);
        else gdn_scan<SHADOW_B>((LAS float*)lds, GQ, GK, GV, ALPHA, BETA, DUMMY, tid, lane, wave); }
#endif
    }
    GRID_BAR();
    }
    _Pragma("unroll 1") for (int rep_ = 0; rep_ < 1 + (int)((DUPMASK >> 5) & 1u); ++rep_) {
    if (PHMASK & (1u << 5)) {
        DECL_PTRS();
        LAS float* scr = (LAS float*)(lds + wave * 8448);
        constexpr int IT_U = 16 * 176, IT_D = 44 * 32;
        for (int it = gw; it < IT_U + IT_D; it += NGW) {
            if (it < IT_U) { const int kb = it / 176, nb = it % 176; const int n0 = 32 * nb; const int hn = n0 < FFH ? n0 : n0 - FFH;
                const int drow = 256 * (hn / 128) + (hn % 128) + (n0 < FFH ? 0 : 128);
                tr_item(args.in[I_FUP], FF2, n0, 64 * kb, WUP_T, 1024, drow, args.in[I_N2G], scr, lane); }
            else { const int r = it - IT_U; const int kb = r / 32, nb = r % 32; tr_item(args.in[I_FDN], 1024, 32 * nb, 64 * kb, WDN_T, FFH, 32 * nb, nullptr, scr, lane); }
        }
        const float* ln_w = args.in[I_LNW]; const float* ln_b = args.in[I_LNB]; const float* r_k = args.in[I_RK]; const float* gnw = args.in[I_GNW];
        const int c = 8 * lane; float lw[8], lb[8], rk[8], nw[8];
#pragma unroll
        for (int e = 0; e < 8; ++e) { lw[e] = ln_w[c + e]; lb[e] = ln_b[c + e]; rk[e] = r_k[c + e]; nw[e] = gnw[(c + e) & 127]; }
        for (int m = gw; m < M_TOK; m += NGW) {
            const size_t off = (size_t)m * 512 + c;
            float y[8], r[8], k[8], v[8], g[8], o[8];
            unpack8(*(const u32x4*)(Yb + off), y); unpack8(*(const u32x4*)(Rb + off), r); unpack8(*(const u32x4*)(Kb + off), k); unpack8(*(const u32x4*)(Vb + off), v); unpack8(*(const u32x4*)(Gb + off), g);
            float s = 0.f, bon = 0.f;
#pragma unroll
            for (int e = 0; e < 8; ++e) { s += y[e]; bon += r[e] * k[e] * rk[e]; }
            s = red8(s); bon = red8(bon); const float mean = s * (1.0f / 64.0f); float q = 0.f;
#pragma unroll
            for (int e = 0; e < 8; ++e) { y[e] -= mean; q += y[e] * y[e]; }
            q = red8(q); const float rstd = __frsqrt_rn(q * (1.0f / 64.0f) + 64e-5f);
#pragma unroll
            for (int e = 0; e < 8; ++e) o[e] = ((y[e] * rstd) * lw[e] + lb[e] + bon * v[e]) * g[e];
            *(u32x4*)(YAB + off) = pack8(o);
            float ov[8], z[8]; unpack8(*(const u32x4*)(Ob + off), ov); unpack8(*(const u32x4*)(PZ + off), z);
            float ms = 0.f;
#pragma unroll
            for (int e = 0; e < 8; ++e) ms += ov[e] * ov[e];
            ms = red16(ms); const float rn = __frsqrt_rn(ms * (1.0f / 128.0f) + 1e-6f);
#pragma unroll
            for (int e = 0; e < 8; ++e) o[e] = ov[e] * rn * nw[e] * siluf_(z[e]);
            *(u32x4*)(YAB + (size_t)M_TOK * 512 + off) = pack8(o);
        }
    }
    GRID_BAR();
    }
    _Pragma("unroll 1") for (int rep_ = 0; rep_ < 1 + (int)((DUPMASK >> 6) & 1u); ++rep_) {
    if (PHMASK & (1u << 6)) {
        DECL_PTRS();
        int kq_ = 512; asm volatile("" : "+s"(kq_));
        pg8::Gemm g{YAB, WPROJ_T, 2 * M_TOK, 2048, kq_}; PairOrder S; S.init(G, bx);
        EpiP6 E{PG, MIX};
        pg8::gemm_phase<EpiP6, PairOrder, true, true>(lds, g, S, E);
    }
    GRID_BAR();
    }
    _Pragma("unroll 1") for (int rep_ = 0; rep_ < 1 + (int)((DUPMASK >> 7) & 1u); ++rep_) {
    if (PHMASK & (1u << 7)) {
        DECL_PTRS();
        int kq_ = 1024; asm volatile("" : "+s"(kq_));
        pg8::Gemm g{MIX, WOUT_T, M_TOK, 1024, kq_}; pg8::StaticOrder S; S.init(M_TOK, 1024, G, bx);
        EpiRes E{x, X2, X2B, RS2, 0};
        pg8::gemm_phase<EpiRes, pg8::StaticOrder, true, true>(lds, g, S, E);
    }
    GRID_BAR();
    }
#pragma unroll 1
    for (int hh = 0; hh < 2; ++hh) {
        const int roff = hh * 16384;
        _Pragma("unroll 1") for (int rep_ = 0; rep_ < 1 + (int)((DUPMASK >> 8) & 1u); ++rep_) {
        if (PHMASK & (1u << 8)) {
        DECL_PTRS();
            int kq_ = 1024; asm volatile("" : "+s"(kq_));
        pg8::Gemm g{X2B + (size_t)roff * 1024, WUP_T, 16384, FF2, kq_}; pg8::StaticOrder S; S.init(16384, FF2, G, bx);
            EpiP8 E{Hh, RS2, roff};
            pg8::gemm_phase<EpiP8, pg8::StaticOrder, true, true>(lds, g, S, E);
        }
        GRID_BAR();
        }
        _Pragma("unroll 1") for (int rep_ = 0; rep_ < 1 + (int)((DUPMASK >> 9) & 1u); ++rep_) {
            if (PHMASK & (1u << 9)) {
        DECL_PTRS();
            const float* fcw = args.in[I_FCONV];
            constexpr int NITEM = (16384 / 16) * 6;
            for (int it = gw; it < NITEM; it += NGW) {
                const int q = it % 6, run = it / 6; const int L = lane + 64 * q; if (L >= 352) continue;
                const int hu = 8 * L, j = L >> 4, cg_ = 256 * j + 8 * (L & 15), cu_ = cg_ + 128;
                float wg0[8], wg1[8], wg2[8], wu0[8], wu1[8], wu2[8], g1[8], g2[8], u1[8], u2[8];
#pragma unroll
                for (int e = 0; e < 8; ++e) { wg0[e] = fcw[hu + e]; wg1[e] = fcw[FF2 + hu + e]; wg2[e] = fcw[2 * FF2 + hu + e];
                    wu0[e] = fcw[FFH + hu + e]; wu1[e] = fcw[FF2 + FFH + hu + e]; wu2[e] = fcw[2 * FF2 + FFH + hu + e]; g1[e] = 0.f; g2[e] = 0.f; u1[e] = 0.f; u2[e] = 0.f; }
                const size_t l0 = (size_t)run * 16; const bool bstart = ((roff + l0) % TSEQ) == 0;
                if (!bstart) { unpack8(*(const u32x4*)(Hh + (l0 - 2) * FF2 + cg_), g2); unpack8(*(const u32x4*)(Hh + (l0 - 1) * FF2 + cg_), g1);
                               unpack8(*(const u32x4*)(Hh + (l0 - 2) * FF2 + cu_), u2); unpack8(*(const u32x4*)(Hh + (l0 - 1) * FF2 + cu_), u1); }
#pragma unroll
                for (int hb = 0; hb < 2; ++hb) {
                    u32x4 rg[8], ru[8];
                    const bf16* ph = Hh + (l0 + hb * 8) * FF2 + cg_; bf16* pa = ACT + (l0 + hb * 8) * FFH + hu; asm volatile("" : "+v"(ph), "+v"(pa));
#pragma unroll
                    for (int i = 0; i < 8; ++i) { rg[i] = *(const u32x4*)(ph + i * FF2); ru[i] = *(const u32x4*)(ph + i * FF2 + 128); }
#pragma unroll
                    for (int i = 0; i < 8; ++i) { float g0[8], u0[8], o[8];
                        unpack8(rg[i], g0); unpack8(ru[i], u0);
#pragma unroll
                        for (int e = 0; e < 8; ++e) { const float cgv = wg0[e] * g2[e] + wg1[e] * g1[e] + wg2[e] * g0[e]; const float cuv = wu0[e] * u2[e] + wu1[e] * u1[e] + wu2[e] * u0[e];
                            o[e] = siluf_(cgv) * cuv; g2[e] = g1[e]; g1[e] = g0[e]; u2[e] = u1[e]; u1[e] = u0[e]; }
                        *(u32x4*)(pa + i * FFH) = pack8(o); }
                }
            }
        }
        GRID_BAR();
        }
            if (PHMASK & (1u << 10)) {
        DECL_PTRS();
            int kq_ = FFH; asm volatile("" : "+s"(kq_));
        pg8::Gemm g{ACT, WDN_T, 16384, 1024, kq_}; pg8::StaticOrder S; S.init(16384, 1024, G, bx);
            EpiRes E{X2, X2, nullptr, RS3, roff};
            pg8::gemm_phase<EpiRes, pg8::StaticOrder, true, true>(lds, g, S, E);
        }
        GRID_BAR();
        }
    if (PHMASK & (1u << 11)) {
        DECL_PTRS();
        const float* fg = args.in[I_FING];
        f32x4 gv[4];
#pragma unroll
        for (int j = 0; j < 4; ++j) gv[j] = *((const f32x4*)fg + lane + 64 * j);
        for (int m = gw; m < M_TOK; m += 4 * NGW) {
            f32x4 v[4][4]; float rs[4];
#pragma unroll
            for (int q = 0; q < 4; ++q) { const int mm = m + q * NGW; rs[q] = RS3[mm];
#pragma unroll
                for (int j = 0; j < 4; ++j) v[q][j] = *((const f32x4*)(X2 + (size_t)mm * DM) + lane + 64 * j); }
#pragma unroll
            for (int q = 0; q < 4; ++q) { const int mm = m + q * NGW; const float r_ = __frsqrt_rn(rs[q] * (1.0f / DM) + 1e-6f);
#pragma unroll
                for (int j = 0; j < 4; ++j) *((f32x4*)(X2 + (size_t)mm * DM) + lane + 64 * j) = v[q][j] * r_ * gv[j]; }
        }
    }
    if (args.never) grid.sync();
}

extern "C" void kernel_launch(void* const* d_in, const int* in_sizes, int n_in, void* d_out, int out_size, void* d_ws, size_t ws_size, hipStream_t stream) {
    static int grid = 0;
    if (grid == 0) {
        if (n_in != 26 || in_sizes[0] != M_TOK * DM || out_size != M_TOK * DM || ws_size < WS_NEED) {
            fprintf(stderr, "kernel_launch: unexpected problem (n_in %d, in0 %d, out %d, ws %zu); nothing launched\n", n_in, n_in > 0 ? in_sizes[0] : -1, out_size, ws_size); grid = -1; return; }
        int dev = 0, cus = 0, per_cu = 0;
        hipGetDevice(&dev); hipDeviceGetAttribute(&cus, hipDeviceAttributeMultiprocessorCount, dev);
        hipFuncSetAttribute((const void*)hybrid_fwd, hipFuncAttributeMaxDynamicSharedMemorySize, LDS_BYTES);
        hipOccupancyMaxActiveBlocksPerMultiprocessor(&per_cu, (const void*)hybrid_fwd, NWAVES * 64, LDS_BYTES);
        (void)hipGetLastError();
        if (per_cu < 1) per_cu = 1;
        grid = cus;
        if (grid != 256) fprintf(stderr, "kernel_launch: %d CUs (expected 256)\n", grid);
    }
    if (grid < 0) return;
    hipMemsetAsync((char*)d_ws + WS_CTL, 0, CTL_ZERO_BYTES, stream);
    Args a{};
    for (int i = 0; i < 26; ++i) a.in[i] = (const float*)d_in[i];
    a.out = (float*)d_out; a.ws = (unsigned char*)d_ws; a.never = 0; a.pad = 0;
    void* kargs[] = {&a};
    hipError_t e = hipLaunchCooperativeKernel((const void*)hybrid_fwd, dim3(grid), dim3(NWAVES * 64), kargs, LDS_BYTES, stream);
    if (e != hipSuccess) fprintf(stderr, "cooperative launch failed: %s (grid %d)\n", hipGetErrorString(e), grid);
}
```
